# Optimizing an MI355X kernel written in HIP

```python
import math
import jax, jax.numpy as jnp
from jax import lax
import numpy as np

D_MODEL = 1024
BATCH = 8
SEQ = 2048
DEPTH = 1

N_MLA_HEADS = 8
D_MLA_NOPE = 64
D_MLA_ROPE = 32
D_MLA_V = 64
Q_LORA = 256
KV_LORA = 128
N_DIFF_HEADS = 8
D_DIFF_HEAD = 64
D_FF = 4 * D_MODEL
ROPE_THETA = 10000.0
Q_BLOCK = 128
EPS = 1e-6

C_QA = Q_LORA
C_KVA = KV_LORA + D_MLA_ROPE
C_DQ = 2 * N_DIFF_HEADS * D_DIFF_HEAD
C_DK = 2 * N_DIFF_HEADS * D_DIFF_HEAD
C_DV = N_DIFF_HEADS * 2 * D_DIFF_HEAD
C_GATE = 2 * D_MODEL
D_IN_TOTAL = C_QA + C_KVA + C_DQ + C_DK + C_DV + C_GATE
D_MLA_OUT = N_MLA_HEADS * D_MLA_V
D_DIFF_OUT = N_DIFF_HEADS * 2 * D_DIFF_HEAD

kernel_name = "hybrid_mla_diffattn_gated_sqrelu"


def rmsnorm(x, g):
    xf = x.astype(jnp.float32)
    y = xf * lax.rsqrt(jnp.mean(xf * xf, axis=-1, keepdims=True) + EPS)
    return (y * g.astype(jnp.float32)).astype(x.dtype)


def rope(x, pos):
    d = x.shape[-1]
    inv_freq = 1.0 / (ROPE_THETA ** (jnp.arange(0, d, 2, dtype=jnp.float32) / d))
    ang = pos[:, None] * inv_freq[None, :]
    cos = jnp.cos(ang)[None, :, None, :]
    sin = jnp.sin(ang)[None, :, None, :]
    xf = x.astype(jnp.float32)
    x1, x2 = xf[..., : d // 2], xf[..., d // 2:]
    out = jnp.concatenate([x1 * cos - x2 * sin, x2 * cos + x1 * sin], axis=-1)
    return out.astype(x.dtype)


def causal_softmax(q_blk, k_pre, q_start, scale):
    s = jnp.einsum('bqhd,bkhd->bhqk', q_blk, k_pre, preferred_element_type=jnp.float32) * scale
    nq, nk = q_blk.shape[1], k_pre.shape[1]
    mask = (q_start + jnp.arange(nq))[:, None] >= jnp.arange(nk)[None, :]
    s = jnp.where(mask[None, None], s, -jnp.inf)
    return jax.nn.softmax(s, axis=-1)


def block_causal_attention(q, k, v, scale, mix_probs):
    S = q.shape[1]
    outs = []
    for start in range(0, S, Q_BLOCK):
        end = start + Q_BLOCK
        p = causal_softmax(q[:, start:end], k[:, :end], start, scale)
        w = mix_probs(p).astype(v.dtype)
        outs.append(jnp.einsum('bhqk,bkhd->bqhd', w, v[:, :end]))
    return jnp.concatenate(outs, axis=1)


def setup_inputs(seed: int = 0) -> dict:
    key = jax.random.key(seed)
    ks = jax.random.split(key, 24)

    def dense(k, fan_in, fan_out):
        return jax.random.normal(k, (DEPTH, fan_in, fan_out), jnp.float32) * fan_in ** -0.5

    def gain(k, d):
        return 1.0 + 0.01 * jax.random.normal(k, (DEPTH, d), jnp.float32)

    return {
        "x": jax.random.normal(ks[0], (BATCH, SEQ, D_MODEL), jnp.float32),
        "pre_attn_g": gain(ks[1], D_MODEL),
        "w_in": dense(ks[2], D_MODEL, D_IN_TOTAL),
        "q_norm_g": gain(ks[3], Q_LORA),
        "w_q_b": dense(ks[4], Q_LORA, N_MLA_HEADS * (D_MLA_NOPE + D_MLA_ROPE)),
        "kv_norm_g": gain(ks[5], KV_LORA),
        "w_kv_b": dense(ks[6], KV_LORA, N_MLA_HEADS * (D_MLA_NOPE + D_MLA_V)),
        "lambda_q1": 0.1 * jax.random.normal(ks[7], (DEPTH, D_DIFF_HEAD), jnp.float32),
        "lambda_k1": 0.1 * jax.random.normal(ks[8], (DEPTH, D_DIFF_HEAD), jnp.float32),
        "lambda_q2": 0.1 * jax.random.normal(ks[9], (DEPTH, D_DIFF_HEAD), jnp.float32),
        "lambda_k2": 0.1 * jax.random.normal(ks[10], (DEPTH, D_DIFF_HEAD), jnp.float32),
        "subln_g": gain(ks[11], 2 * D_DIFF_HEAD),
        "w_br_mla": dense(ks[12], D_MLA_OUT, D_MODEL),
        "w_br_diff": dense(ks[13], D_DIFF_OUT, D_MODEL),
        "w_out": dense(ks[14], D_MODEL, D_MODEL),
        "post_attn_g": gain(ks[15], D_MODEL),
        "pre_mlp_g": gain(ks[16], D_MODEL),
        "w_mlp_up": dense(ks[17], D_MODEL, D_FF),
        "w_mlp_down": dense(ks[18], D_FF, D_MODEL),
        "post_mlp_g": gain(ks[19], D_MODEL),
    }


def reference(x, pre_attn_g, w_in, q_norm_g, w_q_b, kv_norm_g, w_kv_b,
              lambda_q1, lambda_k1, lambda_q2, lambda_k2, subln_g,
              w_br_mla, w_br_diff, w_out, post_attn_g, pre_mlp_g,
              w_mlp_up, w_mlp_down, post_mlp_g):
    B, S, _ = x.shape
    pos = jnp.arange(S, dtype=jnp.float32)
    splits = [C_QA, C_QA + C_KVA, C_QA + C_KVA + C_DQ, C_QA + C_KVA + C_DQ + C_DK,
              C_QA + C_KVA + C_DQ + C_DK + C_DV]
    mla_scale = 1.0 / math.sqrt(D_MLA_NOPE + D_MLA_ROPE)
    diff_scale = 1.0 / math.sqrt(D_DIFF_HEAD)

    for l in range(DEPTH):
        h = rmsnorm(x, pre_attn_g[l])
        proj = jnp.einsum('bsd,de->bse', h, w_in[l])
        qa, kva, dq, dk, dv, gate_logits = jnp.split(proj, splits, axis=-1)

        q = jnp.einsum('bsr,re->bse', rmsnorm(qa, q_norm_g[l]), w_q_b[l])
        q = q.reshape(B, S, N_MLA_HEADS, D_MLA_NOPE + D_MLA_ROPE)
        q_mla = jnp.concatenate([q[..., :D_MLA_NOPE], rope(q[..., D_MLA_NOPE:], pos)], axis=-1)
        c_kv, k_rope = kva[..., :KV_LORA], kva[..., KV_LORA:]
        k_rope = rope(k_rope[:, :, None, :], pos)
        kv = jnp.einsum('bsr,re->bse', rmsnorm(c_kv, kv_norm_g[l]), w_kv_b[l])
        kv = kv.reshape(B, S, N_MLA_HEADS, D_MLA_NOPE + D_MLA_V)
        k_nope, v_mla = kv[..., :D_MLA_NOPE], kv[..., D_MLA_NOPE:]
        k_mla = jnp.concatenate(
            [k_nope, jnp.broadcast_to(k_rope, (B, S, N_MLA_HEADS, D_MLA_ROPE))], axis=-1)
        o_mla = block_causal_attention(q_mla, k_mla, v_mla, mla_scale, lambda p: p)
        u_mla = jnp.einsum('bse,ed->bsd', o_mla.reshape(B, S, D_MLA_OUT), w_br_mla[l])

        lam_init = 0.8 - 0.6 * math.exp(-0.3 * l)
        lam = (jnp.exp(jnp.sum(lambda_q1[l].astype(jnp.float32) * lambda_k1[l].astype(jnp.float32)))
               - jnp.exp(jnp.sum(lambda_q2[l].astype(jnp.float32) * lambda_k2[l].astype(jnp.float32)))
               + lam_init)
        q_d = rope(dq.reshape(B, S, 2 * N_DIFF_HEADS, D_DIFF_HEAD), pos)
        k_d = rope(dk.reshape(B, S, 2 * N_DIFF_HEADS, D_DIFF_HEAD), pos)
        v_d = dv.reshape(B, S, N_DIFF_HEADS, 2 * D_DIFF_HEAD)

        def diff_mix(p):
            p = p.reshape(B, N_DIFF_HEADS, 2, p.shape[2], p.shape[3])
            return p[:, :, 0] - lam * p[:, :, 1]

        o_d = block_causal_attention(q_d, k_d, v_d, diff_scale, diff_mix)
        o_d = rmsnorm(o_d, subln_g[l]) * (1.0 - lam_init)
        u_diff = jnp.einsum('bse,ed->bsd', o_d.reshape(B, S, D_DIFF_OUT), w_br_diff[l])

        g_mla, g_diff = jnp.split(gate_logits, 2, axis=-1)
        mixed = jax.nn.sigmoid(g_mla) * u_mla + jax.nn.sigmoid(g_diff) * u_diff
        y = jnp.einsum('bsd,de->bse', mixed, w_out[l])
        x = x + rmsnorm(y, post_attn_g[l])

        h = rmsnorm(x, pre_mlp_g[l])
        m = jnp.square(jax.nn.relu(jnp.einsum('bsd,df->bsf', h, w_mlp_up[l])))
        m = jnp.einsum('bsf,fd->bsd', m, w_mlp_down[l])
        x = x + rmsnorm(m, post_mlp_g[l])
    return x
```

```cpp
#include <hip/hip_runtime.h>
#include <hip/hip_cooperative_groups.h>
#include <cstdio>
#include <cstdint>
namespace cg = cooperative_groups;
#define MK_N_LAUNCHES 1
namespace pg8 {
#define PG8_LAS __attribute__((address_space(3)))
typedef unsigned short bf16_t;
typedef short bf16x8 __attribute__((ext_vector_type(8)));
typedef float f32x4 __attribute__((ext_vector_type(4)));
typedef unsigned u32x4 __attribute__((ext_vector_type(4)));
constexpr int BM = 256, BK = 64, HALF = 128, HTB = HALF * BK * 2  , STAGE_BYTES = 8 * HTB, NXCD = 8, WGM = 8;

__host__ __device__ __forceinline__ int lds_byte(int r, int c) { const int st = (r >> 4) * 2 + (c >> 5), rr = r & 15, cc = c & 31, ob = rr * 64 + cc * 2; return st * 1024 + (ob ^ (((ob >> 9) & 1) << 5)); }
__host__ __device__ __forceinline__ void stage_rc(int b, int& R, int& C) { const int st = b / 1024, sb = b % 1024, swz = sb ^ (((sb >> 9) & 1) << 5); R = (st >> 1) * 16 + swz / 64; C = (st & 1) * 32 + (swz % 64) / 2; }
__host__ __device__ __forceinline__ int perm32(int rho) { const int n = rho >> 4, i = rho & 15; return 8 * (i >> 2) + 4 * n + (i & 3); }

struct Unit { int pm, pn; };
struct Gemm { const bf16_t* A; const bf16_t* Bt; int M, N, K; };

struct StaticOrder {
    int nM, nN, nwg, G, c;
    __host__ __device__ void init(int M, int N, int G_, int c_) { nM = M / BM; nN = N / BM; nwg = nM * nN; G = G_; c = c_; }
    __host__ __device__ bool next(int i, Unit& u) const {
        const long L = (long)i * G + c; if (L >= nwg) return false;
        int wgid = (int)L; { const int q = nwg / NXCD, r = nwg % NXCD, xcd = wgid % NXCD, off = wgid / NXCD; wgid = (xcd < r ? xcd * (q + 1) : r * (q + 1) + (xcd - r) * q) + off; }
        const int nig = WGM * nN, gid = wgid / nig, fm = gid * WGM, gsz = (nM - fm) < WGM ? (nM - fm) : WGM;
        u.pm = fm + ((wgid % nig) % gsz); u.pn = (wgid % nig) / gsz; return true;
    }
    __device__ __forceinline__ void a_ready(const Unit&) const {}
    __device__ __forceinline__ void done(const Unit&) const {}
};

__device__ __forceinline__ unsigned cvt_pk_bf16(float lo, float hi) { unsigned r; asm volatile("v_cvt_pk_bf16_f32 %0, %1, %2" : "=v"(r) : "v"(lo), "v"(hi)); return r; }
typedef float f32x2 __attribute__((ext_vector_type(2)));
template <class Epi, class Sched, bool ALIGN_EPI = false, bool SP2 = false>
__device__ __forceinline__ void gemm_phase(PG8_LAS unsigned char* lds, const Gemm g, const Sched& S, const Epi& E) {
    const int tid = threadIdx.x, wid = __builtin_amdgcn_readfirstlane(tid >> 6), lane = tid & 63, wr = wid >> 2, wc = wid & 3, fr = lane & 15, fq = lane >> 4;
    const int K = g.K, nt = K / BK;
    unsigned voffA[2], voffB[2];
#pragma unroll
    for (int i = 0; i < 2; ++i) { int R, C; stage_rc(tid * 16 + i * 8192, R, C); const int Rb = Epi::PERM ? ((R & ~31) + perm32(R & 31)) : R;
        voffA[i] = (unsigned)(R * K + C) * 2u; voffB[i] = (unsigned)(Rb * K + C) * 2u; }
    const size_t kstep = (size_t)(BK * 2);
    const size_t hstep = (size_t)HALF * K * 2;
    const size_t tstep = 2 * hstep;
    const unsigned ldsw = (unsigned)wid * 1024u;
    const int aoff = lds_byte(wr * 64 + fr, fq * 8), boff = lds_byte(wc * 32 + fr, fq * 8);
#define PG8_SA(b, h) (((b) * 2 + (h)) * HTB)
#define PG8_SB(b, h) ((4 + (b) * 2 + (h)) * HTB)
#define PG8_STAGE(bufoff, gbase, voff) do { _Pragma("unroll") for (int _i = 0; _i < 2; ++_i) \
        __builtin_amdgcn_global_load_lds((const unsigned*)((const char*)(gbase) + (voff)[_i]), (PG8_LAS unsigned*)(lds + (bufoff) + ldsw + _i * 8192), 16, 0, 0); } while (0)
#define PG8_LDA(dst, b, h) do { _Pragma("unroll") for (int m = 0; m < 4; ++m) _Pragma("unroll") for (int k = 0; k < 2; ++k) dst[m][k] = *(const PG8_LAS bf16x8*)(lds + PG8_SA(b, h) + aoff + m * 2048 + k * 1024); } while (0)
#define PG8_LDB(dst, b, h) do { _Pragma("unroll") for (int n = 0; n < 2; ++n) _Pragma("unroll") for (int k = 0; k < 2; ++k) dst[n][k] = *(const PG8_LAS bf16x8*)(lds + PG8_SB(b, h) + boff + n * 2048 + k * 1024); } while (0)
#define PG8_MMA(ai, bj, At, Bt) do { __builtin_amdgcn_s_setprio(1); _Pragma("unroll") for (int m = 0; m < 4; ++m) _Pragma("unroll") for (int n = 0; n < 2; ++n) _Pragma("unroll") for (int k = 0; k < 2; ++k) \
        acc[ai][bj][m][n] = __builtin_amdgcn_mfma_f32_16x16x32_bf16(Bt[n][k], At[m][k], acc[ai][bj][m][n], 0, 0, 0); __builtin_amdgcn_s_setprio(0); } while (0)
#define PG8_WAIT_V(n) asm volatile("s_waitcnt vmcnt(" #n ")" ::: "memory")
#define PG8_WAIT_L(n) asm volatile("s_waitcnt lgkmcnt(" #n ")" ::: "memory")
#define PG8_BAR __builtin_amdgcn_s_barrier()
#define PG8_SCHED __builtin_amdgcn_sched_barrier(0)
    Unit cur, nxt; int ui = 0;
    if (!S.next(0, cur)) return;
    f32x4 acc[2][2][4][2];
#pragma unroll
    for (int a = 0; a < 2; ++a)
#pragma unroll
        for (int b = 0; b < 2; ++b)
#pragma unroll
            for (int m = 0; m < 4; ++m)
#pragma unroll
                for (int n = 0; n < 2; ++n) acc[a][b][m][n] = (f32x4){0.f, 0.f, 0.f, 0.f};
    bf16x8 At[4][2], B0[2][2], B1[2][2];
    const char* cA = (const char*)g.A + (size_t)cur.pm * tstep; const char* cB = (const char*)g.Bt + (size_t)cur.pn * tstep;
    S.a_ready(cur);
    if constexpr (SP2) {
        PG8_STAGE(PG8_SB(0, 0), cB, voffB); PG8_STAGE(PG8_SB(0, 1), cB + hstep, voffB); PG8_STAGE(PG8_SA(0, 0), cA, voffA); PG8_STAGE(PG8_SA(0, 1), cA + hstep, voffA);
        if (wr == 1) PG8_BAR;
        PG8_WAIT_V(2); PG8_BAR;
        PG8_STAGE(PG8_SB(1, 0), cB + kstep, voffB); PG8_STAGE(PG8_SA(1, 0), cA + kstep, voffA); PG8_STAGE(PG8_SB(1, 1), cB + hstep + kstep, voffB);
        PG8_WAIT_V(6); PG8_BAR;
    } else {
        PG8_STAGE(PG8_SB(0, 0), cB, voffB); PG8_STAGE(PG8_SA(0, 0), cA, voffA); PG8_STAGE(PG8_SB(0, 1), cB + hstep, voffB); PG8_STAGE(PG8_SA(0, 1), cA + hstep, voffA);
        if (wr == 1) PG8_BAR;
        PG8_WAIT_V(4); PG8_BAR;
        PG8_STAGE(PG8_SB(1, 0), cB + kstep, voffB); PG8_STAGE(PG8_SA(1, 0), cA + kstep, voffA); PG8_STAGE(PG8_SB(1, 1), cB + hstep + kstep, voffB);
        PG8_WAIT_V(6); PG8_BAR;
    }
    for (;;) {
        const bool has_next = S.next(ui + 1, nxt);
        const char* nA = has_next ? (const char*)g.A + (size_t)nxt.pm * tstep : cA; const char* nB = has_next ? (const char*)g.Bt + (size_t)nxt.pn * tstep : cB;
        for (int t = 0; t < nt; t += 2) {
            const bool last = (t == nt - 2);
            const char* a1 = cA + (size_t)(t + 1) * kstep;
            const char* a2 = last ? nA : cA + (size_t)(t + 2) * kstep; const char* b2 = last ? nB : cB + (size_t)(t + 2) * kstep;
            const char* a3 = a2 + kstep; const char* b3 = b2 + kstep;
            if (last && has_next) S.a_ready(nxt);
            if constexpr (SP2) {
            PG8_LDB(B0, 0, 0); PG8_LDB(B1, 0, 1); PG8_SCHED; PG8_LDA(At, 0, 0); PG8_STAGE(PG8_SA(1, 1), a1 + hstep, voffA);
            PG8_WAIT_V(8); PG8_WAIT_L(0); PG8_BAR; PG8_MMA(0, 0, At, B0); PG8_MMA(0, 1, At, B1); PG8_BAR; PG8_SCHED;
            PG8_LDA(At, 0, 1); PG8_STAGE(PG8_SB(0, 0), b2, voffB); PG8_STAGE(PG8_SB(0, 1), b2 + hstep, voffB); PG8_STAGE(PG8_SA(0, 0), a2, voffA);
            PG8_WAIT_V(8); PG8_WAIT_L(0); PG8_BAR; PG8_MMA(1, 0, At, B0); PG8_MMA(1, 1, At, B1); PG8_BAR; PG8_SCHED;
            PG8_LDB(B0, 1, 0); PG8_LDB(B1, 1, 1); PG8_SCHED; PG8_LDA(At, 1, 0); PG8_STAGE(PG8_SA(0, 1), a2 + hstep, voffA);
            PG8_WAIT_V(8); PG8_WAIT_L(0); PG8_BAR; PG8_MMA(0, 0, At, B0); PG8_MMA(0, 1, At, B1); PG8_BAR; PG8_SCHED;
            PG8_LDA(At, 1, 1); PG8_STAGE(PG8_SB(1, 0), b3, voffB); PG8_STAGE(PG8_SB(1, 1), b3 + hstep, voffB); PG8_STAGE(PG8_SA(1, 0), a3, voffA);
            PG8_WAIT_V(8); PG8_WAIT_L(0); PG8_BAR; PG8_MMA(1, 0, At, B0); PG8_MMA(1, 1, At, B1); PG8_BAR; PG8_SCHED;
            } else {
            PG8_LDB(B0, 0, 0); PG8_SCHED; PG8_LDA(At, 0, 0); PG8_STAGE(PG8_SA(1, 1), a1 + hstep, voffA);
            PG8_WAIT_L(8); PG8_BAR; PG8_WAIT_L(0); PG8_MMA(0, 0, At, B0); PG8_BAR; PG8_SCHED;
            PG8_LDB(B1, 0, 1); PG8_STAGE(PG8_SB(0, 0), b2, voffB);
            PG8_BAR; PG8_WAIT_L(0); PG8_MMA(0, 1, At, B1); PG8_BAR;
            PG8_LDA(At, 0, 1); PG8_STAGE(PG8_SA(0, 0), a2, voffA);
            PG8_BAR; PG8_WAIT_L(0); PG8_MMA(1, 0, At, B0); PG8_BAR; PG8_SCHED;
            PG8_STAGE(PG8_SB(0, 1), b2 + hstep, voffB);
            PG8_WAIT_V(6); PG8_BAR; PG8_MMA(1, 1, At, B1); PG8_BAR;
            PG8_LDB(B0, 1, 0); PG8_SCHED; PG8_LDA(At, 1, 0); PG8_STAGE(PG8_SA(0, 1), a2 + hstep, voffA);
            PG8_WAIT_L(8); PG8_BAR; PG8_WAIT_L(0); PG8_MMA(0, 0, At, B0); PG8_BAR; PG8_SCHED;
            PG8_LDB(B1, 1, 1); PG8_STAGE(PG8_SB(1, 0), b3, voffB);
            PG8_BAR; PG8_WAIT_L(0); PG8_MMA(0, 1, At, B1); PG8_BAR;
            PG8_LDA(At, 1, 1); PG8_STAGE(PG8_SA(1, 0), a3, voffA);
            PG8_BAR; PG8_WAIT_L(0); PG8_MMA(1, 0, At, B0); PG8_BAR; PG8_SCHED;
            PG8_STAGE(PG8_SB(1, 1), b3 + hstep, voffB);
            PG8_WAIT_V(6); PG8_BAR; PG8_MMA(1, 1, At, B1); PG8_BAR;
            }
        }
        if constexpr (ALIGN_EPI) { if (wr == 0) PG8_BAR; }
        if constexpr (!Epi::AFTER_DRAIN) { E(acc, cur, wr, wc, fr, fq); S.done(cur); }
        if (!has_next) break;
#pragma unroll
        for (int a = 0; a < 2; ++a)
#pragma unroll
            for (int b = 0; b < 2; ++b)
#pragma unroll
                for (int m = 0; m < 4; ++m)
#pragma unroll
                    for (int n = 0; n < 2; ++n) acc[a][b][m][n] = (f32x4){0.f, 0.f, 0.f, 0.f};
        cur = nxt; cA = nA; cB = nB; ++ui;
        if constexpr (ALIGN_EPI) { if (wr == 1) PG8_BAR; }
    }
    PG8_WAIT_V(0);
    if constexpr (!ALIGN_EPI) { if (wr == 0) PG8_BAR; }
    PG8_BAR;
    if constexpr (Epi::AFTER_DRAIN) { E.fused(acc, cur, wr, wc, fr, fq, lds, wid, lane); S.done(cur); }
#undef PG8_SA
#undef PG8_SB
#undef PG8_STAGE
#undef PG8_LDA
#undef PG8_LDB
#undef PG8_MMA
#undef PG8_WAIT_V
#undef PG8_WAIT_L
#undef PG8_BAR
#undef PG8_SCHED
}
}

#ifndef MK_N_LAUNCHES
#define MK_N_LAUNCHES 1
#endif
#define DI __device__ __forceinline__
#define LAS __attribute__((address_space(3)))
constexpr int BATCH = 8, SEQ = 2048, DM = 1024, M = BATCH * SEQ, FF = 4096;
constexpr int NPROJ = 5632;
constexpr float EPS = 1e-6f, LOG2E = 1.4426950408889634f;
constexpr float QS_MLA = 0.10206207261596575f * LOG2E, QS_DIFF = 0.125f * LOG2E;
constexpr size_t MiB = 1u << 20;
constexpr size_t WS_WIN = 2 * MiB, WS_WUP = 13 * MiB, WS_WDOWN = 21 * MiB, WS_WBRD = 29 * MiB, WS_WOUT = 31 * MiB, WS_WBRM = 33 * MiB, WS_WQB = 34 * MiB, WS_WKVB = 34 * MiB + 512 * 1024;
constexpr size_t WS_QD = 36 * MiB, WS_KD = 68 * MiB, WS_VD = 100 * MiB, WS_QM = 132 * MiB, WS_KM = 156 * MiB, WS_VM = 180 * MiB, WS_QA = 196 * MiB, WS_CKV = 204 * MiB, WS_XN = 208 * MiB;
constexpr size_t WS_OM = WS_XN, WS_MIX = WS_KD, WS_T = WS_QM, WS_Y = WS_QM, WS_H = 36 * MiB, WS_MO = 164 * MiB, WS_CTL = 240 * MiB;
constexpr size_t CT_SSQ = 0, CT_SSKV = 256 * 1024, CT_SSY = 512 * 1024, CT_SSM = 1536 * 1024, CT_RD = 2560 * 1024, CT_RM = 3072 * 1024;
constexpr int LDS_BYTES = 147456;
constexpr int NPH = 10;

using pg8::f32x4; using pg8::u32x4; using pg8::bf16_t; using pg8::Unit;
typedef float f32x2_t __attribute__((ext_vector_type(2))); typedef __bf16 bf16x2_t __attribute__((ext_vector_type(2)));
DI unsigned cvt_pk_bf16(float lo, float hi) { const f32x2_t v = {lo, hi}; const bf16x2_t b = __builtin_convertvector(v, bf16x2_t); return __builtin_bit_cast(unsigned, b); }
typedef unsigned u32x2 __attribute__((ext_vector_type(2)));

DI u32x4 pack8(f32x4 a, f32x4 b) { u32x4 w; w.x = cvt_pk_bf16(a[0], a[1]); w.y = cvt_pk_bf16(a[2], a[3]); w.z = cvt_pk_bf16(b[0], b[1]); w.w = cvt_pk_bf16(b[2], b[3]); return w; }
DI u32x2 pack4(f32x4 a) { u32x2 w; w.x = cvt_pk_bf16(a[0], a[1]); w.y = cvt_pk_bf16(a[2], a[3]); return w; }
DI float bf_lo(unsigned w) { return __uint_as_float(w << 16); }
DI float bf_hi(unsigned w) { return __uint_as_float(w & 0xffff0000u); }
DI float sumsq4(f32x4 a) { return (a[0] * a[0] + a[1] * a[1]) + (a[2] * a[2] + a[3] * a[3]); }
DI float wave_sum(float v) {
#pragma unroll
    for (int o = 1; o < 64; o <<= 1) v += __shfl_xor(v, o);
    return v;
}
DI void rope4(f32x4& a, f32x4& b, const float* tab) {
    const f32x4 t0 = *(const f32x4*)tab, t1 = *(const f32x4*)(tab + 4);
    const f32x4 c = {t0[0], t0[2], t1[0], t1[2]}, s = {t0[1], t0[3], t1[1], t1[3]};
    const f32x4 lo = a * c - b * s, hi = b * c + a * s; a = lo; b = hi;
}
DI f32x4 sig4(f32x4 v) { f32x4 o;
#pragma unroll
    for (int e = 0; e < 4; ++e) o[e] = __builtin_amdgcn_rcpf(1.0f + __builtin_amdgcn_exp2f(-v[e] * LOG2E));
    return o; }

#define ACC_ARG const f32x4 (&acc)[2][2][4][2]
#define FOR_AM _Pragma("unroll") for (int ai = 0; ai < 2; ++ai) _Pragma("unroll") for (int m = 0; m < 4; ++m)
struct EpiProj {
    static constexpr bool PERM = true, AFTER_DRAIN = false;
    bf16_t *QA, *CKV, *KM, *QD, *KD, *VD, *G; float *ssq, *sskv; const float *RD, *RM;
    DI void operator()(ACC_ARG, const Unit& u, int wr, int wc, int fr, int fq) const {
        asm volatile("" : "+v"(fr), "+v"(fq));
        const int pn = u.pn, rb = u.pm * 256 + wr * 64 + fr, cw = wc * 32 + fq * 8;
        if (pn == 0) {
            FOR_AM { const int row = rb + ai * 128 + m * 16; float s = 0.f;
#pragma unroll
                for (int bj = 0; bj < 2; ++bj) { const f32x4 v0 = acc[ai][bj][m][0], v1 = acc[ai][bj][m][1]; s += sumsq4(v0) + sumsq4(v1);
                    *(u32x4*)(QA + (size_t)row * 256 + bj * 128 + cw) = pack8(v0, v1); }
                s += __shfl_xor(s, 16); s += __shfl_xor(s, 32); if (fq == 0) ssq[row * 4 + wc] = s; }
        } else if (pn == 1) {
            FOR_AM { const int row = rb + ai * 128 + m * 16; const f32x4 v0 = acc[ai][0][m][0], v1 = acc[ai][0][m][1];
                float s = sumsq4(v0) + sumsq4(v1);
                *(u32x4*)(CKV + (size_t)row * 128 + cw) = pack8(v0, v1);
                s += __shfl_xor(s, 16); s += __shfl_xor(s, 32); if (fq == 0) sskv[row * 4 + wc] = s;
                if (wc == 0) { f32x4 a = acc[ai][1][m][0], b = acc[ai][1][m][1]; const int pos = row & (SEQ - 1);
                    rope4(a, b, RM + (pos * 16 + 4 * fq) * 2); const u32x2 lo = pack4(a), hi = pack4(b);
#pragma unroll
                    for (int h = 0; h < 8; ++h) { bf16_t* kp = KM + (size_t)row * 768 + h * 96 + 64 + 4 * fq; *(u32x2*)kp = lo; *(u32x2*)(kp + 16) = hi; } } }
        } else if (pn < 10) {
            const bool isq = pn < 6; bf16_t* dst = isq ? QD : KD; const int ct = (isq ? pn - 2 : pn - 6) * 256; const float sc = isq ? QS_DIFF : 1.f;
            const int g = 4 * (wc & 1) + fq;
            FOR_AM { const int row = rb + ai * 128 + m * 16, pos = row & (SEQ - 1);
#pragma unroll
                for (int bj = 0; bj < 2; ++bj) { f32x4 a = acc[ai][bj][m][0], b = acc[ai][bj][m][1]; rope4(a, b, RD + (pos * 32 + 4 * g) * 2); a = a * sc; b = b * sc;
                    bf16_t* p = dst + (size_t)row * 1024 + ct + (2 * bj + (wc >> 1)) * 64 + 4 * g; *(u32x2*)p = pack4(a); *(u32x2*)(p + 32) = pack4(b); } }
        } else if (pn < 14) {
            FOR_AM { const int row = rb + ai * 128 + m * 16;
#pragma unroll
                for (int bj = 0; bj < 2; ++bj) *(u32x4*)(VD + (size_t)row * 1024 + (pn - 10) * 256 + bj * 128 + cw) = pack8(acc[ai][bj][m][0], acc[ai][bj][m][1]); }
        } else {
            FOR_AM { const int row = rb + ai * 128 + m * 16;
#pragma unroll
                for (int bj = 0; bj < 2; ++bj) *(u32x4*)(G + (size_t)row * 2048 + (pn - 14) * 256 + bj * 128 + cw) = pack8(sig4(acc[ai][bj][m][0]), sig4(acc[ai][bj][m][1])); }
        }
    }
};
struct EpiQ {
    static constexpr bool PERM = true, AFTER_DRAIN = false;
    const float* ssq; bf16_t* QM; const float* RM;
    DI void operator()(ACC_ARG, const Unit& u, int wr, int wc, int fr, int fq) const {
        asm volatile("" : "+v"(fr), "+v"(fq));
        const int pn = u.pn, rb = u.pm * 256 + wr * 64 + fr, cw = wc * 32 + fq * 8;
        FOR_AM { const int row = rb + ai * 128 + m * 16; const f32x4 s4 = *(const f32x4*)(ssq + row * 4);
            const float rs = rsqrtf(((s4[0] + s4[1]) + (s4[2] + s4[3])) * (1.f / 256.f) + EPS) * QS_MLA;
            if (pn < 2) {
#pragma unroll
                for (int bj = 0; bj < 2; ++bj) { const int c = pn * 256 + bj * 128 + cw;
                    *(u32x4*)(QM + (size_t)row * 768 + (c >> 6) * 96 + (c & 63)) = pack8(acc[ai][bj][m][0] * rs, acc[ai][bj][m][1] * rs); }
            } else { const int pos = row & (SEQ - 1);
#pragma unroll
                for (int bj = 0; bj < 2; ++bj) { f32x4 a = acc[ai][bj][m][0] * rs, b = acc[ai][bj][m][1] * rs; rope4(a, b, RM + (pos * 16 + 4 * fq) * 2);
                    bf16_t* p = QM + (size_t)row * 768 + (4 * bj + wc) * 96 + 64 + 4 * fq; *(u32x2*)p = pack4(a); *(u32x2*)(p + 16) = pack4(b); } }
            asm volatile("" ::: "memory");
        }
    }
};
struct EpiKV {
    static constexpr bool PERM = true, AFTER_DRAIN = false;
    const float* sskv; bf16_t *KM, *VM;
    DI void operator()(ACC_ARG, const Unit& u, int wr, int wc, int fr, int fq) const {
        asm volatile("" : "+v"(fr), "+v"(fq));
        const int pn = u.pn, rb = u.pm * 256 + wr * 64 + fr;
        FOR_AM { const int row = rb + ai * 128 + m * 16; const f32x4 s4 = *(const f32x4*)(sskv + row * 4);
            const float rs = rsqrtf(((s4[0] + s4[1]) + (s4[2] + s4[3])) * (1.f / 128.f) + EPS);
#pragma unroll
            for (int bj = 0; bj < 2; ++bj) { const int head = 2 * pn + bj; const u32x4 w = pack8(acc[ai][bj][m][0] * rs, acc[ai][bj][m][1] * rs);
                if (wc < 2) *(u32x4*)(KM + (size_t)row * 768 + head * 96 + wc * 32 + fq * 8) = w;
                else        *(u32x4*)(VM + (size_t)row * 512 + head * 64 + (wc - 2) * 32 + fq * 8) = w; }
            asm volatile("" ::: "memory");
        }
    }
};
struct EpiBr1 {
    static constexpr bool PERM = true, AFTER_DRAIN = false;
    const bf16_t* G; float* T;
    DI void operator()(ACC_ARG, const Unit& u, int wr, int wc, int fr, int fq) const {
        asm volatile("" : "+v"(fr), "+v"(fq));
        const int rb = u.pm * 256 + wr * 64 + fr, cb = u.pn * 256 + wc * 32 + fq * 8;
        FOR_AM { const int row = rb + ai * 128 + m * 16;
#pragma unroll
            for (int bj = 0; bj < 2; ++bj) { const int c = cb + bj * 128; const u32x4 gw = *(const u32x4*)(G + (size_t)row * 2048 + c);
                const f32x4 g0 = {bf_lo(gw.x), bf_hi(gw.x), bf_lo(gw.y), bf_hi(gw.y)}, g1 = {bf_lo(gw.z), bf_hi(gw.z), bf_lo(gw.w), bf_hi(gw.w)};
                float* tp = T + (size_t)row * 1024 + c; *(f32x4*)tp = acc[ai][bj][m][0] * g0; *(f32x4*)(tp + 4) = acc[ai][bj][m][1] * g1; } }
    }
};
struct EpiBr2 {
    static constexpr bool PERM = true, AFTER_DRAIN = false;
    const bf16_t* G; const float* T; bf16_t* MIX;
    DI void operator()(ACC_ARG, const Unit& u, int wr, int wc, int fr, int fq) const {
        asm volatile("" : "+v"(fr), "+v"(fq));
        const int rb = u.pm * 256 + wr * 64 + fr, cb = u.pn * 256 + wc * 32 + fq * 8;
        FOR_AM { const int row = rb + ai * 128 + m * 16;
#pragma unroll
            for (int bj = 0; bj < 2; ++bj) { const int c = cb + bj * 128; const u32x4 gw = *(const u32x4*)(G + (size_t)row * 2048 + 1024 + c);
                const f32x4 g0 = {bf_lo(gw.x), bf_hi(gw.x), bf_lo(gw.y), bf_hi(gw.y)}, g1 = {bf_lo(gw.z), bf_hi(gw.z), bf_lo(gw.w), bf_hi(gw.w)};
                const float* tp = T + (size_t)row * 1024 + c; const f32x4 t0 = *(const f32x4*)tp, t1 = *(const f32x4*)(tp + 4);
                *(u32x4*)(MIX + (size_t)row * 1024 + c) = pack8(t0 + acc[ai][bj][m][0] * g0, t1 + acc[ai][bj][m][1] * g1); } }
    }
};
struct EpiF32SS {
    static constexpr bool PERM = true, AFTER_DRAIN = false;
    float* O; float* ss;
    DI void operator()(ACC_ARG, const Unit& u, int wr, int wc, int fr, int fq) const {
        asm volatile("" : "+v"(fr), "+v"(fq));
        const int rb = u.pm * 256 + wr * 64 + fr, cb = u.pn * 256 + wc * 32 + fq * 8;
        FOR_AM { const int row = rb + ai * 128 + m * 16; float s = 0.f;
#pragma unroll
            for (int bj = 0; bj < 2; ++bj) { const f32x4 v0 = acc[ai][bj][m][0], v1 = acc[ai][bj][m][1]; s += sumsq4(v0) + sumsq4(v1);
                float* op = O + (size_t)row * 1024 + cb + bj * 128; *(f32x4*)op = v0; *(f32x4*)(op + 4) = v1; }
            s += __shfl_xor(s, 16); s += __shfl_xor(s, 32); if (fq == 0) ss[row * 16 + u.pn * 4 + wc] = s; }
    }
};
struct EpiUp {
    static constexpr bool PERM = true, AFTER_DRAIN = false;
    bf16_t* H;
    DI void operator()(ACC_ARG, const Unit& u, int wr, int wc, int fr, int fq) const {
        asm volatile("" : "+v"(fr), "+v"(fq));
        const int rb = u.pm * 256 + wr * 64 + fr, cb = u.pn * 256 + wc * 32 + fq * 8;
        FOR_AM { const int row = rb + ai * 128 + m * 16;
#pragma unroll
            for (int bj = 0; bj < 2; ++bj) { f32x4 v0 = acc[ai][bj][m][0], v1 = acc[ai][bj][m][1];
#pragma unroll
                for (int e = 0; e < 4; ++e) { const float a = fmaxf(v0[e], 0.f), b = fmaxf(v1[e], 0.f); v0[e] = a * a; v1[e] = b * b; }
                *(u32x4*)(H + (size_t)row * FF + cb + bj * 128) = pack8(v0, v1); } }
    }
};

template <int MODE> DI int src_col(int c) {
    if (MODE == 0) return c;
    if (MODE == 1) {
        if (c < 256) return c;
        if (c < 512) { int p = c - 256; if (p < 128) return 256 + p; p -= 128; if (p >= 32) return -1; return 384 + 16 * ((p >> 2) & 1) + 4 * (p >> 3) + (p & 3); }
        if (c < 2560) { const int cr = c - 512, head = cr >> 6, p = cr & 63; return 416 + head * 64 + 32 * ((p >> 2) & 1) + 4 * (p >> 3) + (p & 3); }
        return c - 96;
    }
    if (c < 512) return (c >> 6) * 96 + (c & 63);
    const int cr = c - 512, head = cr >> 5, p = cr & 31; return head * 96 + 64 + 16 * ((p >> 2) & 1) + 4 * (p >> 3) + (p & 3);
}
template <int MODE> DI void transpose_item(const float* W, int K, int Nsrc, int Ngemm, bf16_t* WT, const float* gain, LAS float* scr, int item, int lane) {
    const int nblk = Ngemm / 32, kb = item / nblk, nb = item % nblk, k0 = 64 * kb, n0 = 32 * nb;
    const int sc = src_col<MODE>(n0 + (lane & 31));
#pragma unroll 8
    for (int i = 0; i < 32; ++i) { const int kk = 2 * i + (lane >> 5); float v = 0.f;
        if (sc >= 0) { v = W[(size_t)(k0 + kk) * Nsrc + sc]; if (gain) v *= gain[k0 + kk]; }
        scr[kk * 33 + (lane & 31)] = v; }
    asm volatile("s_waitcnt lgkmcnt(0)" ::: "memory");
    const int c = lane & 7;
#pragma unroll
    for (int j = 0; j < 4; ++j) { const int n = (lane >> 3) + 8 * j; const LAS float* s = scr + (8 * c) * 33 + n;
        u32x4 o; o.x = cvt_pk_bf16(s[0 * 33], s[1 * 33]); o.y = cvt_pk_bf16(s[2 * 33], s[3 * 33]); o.z = cvt_pk_bf16(s[4 * 33], s[5 * 33]); o.w = cvt_pk_bf16(s[6 * 33], s[7 * 33]);
        *(u32x4*)(WT + (size_t)(n0 + n) * K + k0 + 8 * c) = o; }
    asm volatile("s_waitcnt lgkmcnt(0)" ::: "memory");
}
DI void rope_entry(float* dst, int pos, float expo) {
    const float inv = __builtin_amdgcn_exp2f(-expo * 13.287712379549449f);
    const float ang = (float)pos * inv;
    const double rev = (double)ang * 0.15915494309189535;
    const float fr = (float)(rev - __builtin_rint(rev));
    dst[0] = __builtin_amdgcn_cosf(fr); dst[1] = __builtin_amdgcn_sinf(fr);
}
DI void rms_row_to_bf16(const float* xrow, const float* g, bf16_t* orow, int lane) {
    const f32x4* xr = (const f32x4*)xrow + lane; const f32x4* gr = (const f32x4*)g + lane;
    f32x4 v[4]; float s = 0.f;
#pragma unroll
    for (int j = 0; j < 4; ++j) { v[j] = xr[64 * j]; s += sumsq4(v[j]); }
    const float rs = rsqrtf(wave_sum(s) * (1.f / DM) + EPS);
    u32x2* o8 = (u32x2*)orow + lane;
#pragma unroll
    for (int j = 0; j < 4; ++j) o8[64 * j] = pack4(v[j] * rs * gr[64 * j]);
}

namespace att {
typedef short bf16x8 __attribute__((ext_vector_type(8)));
typedef short s16x4 __attribute__((ext_vector_type(4)));
typedef float f32x16 __attribute__((ext_vector_type(16)));
#define MFMA32(a, b, c) __builtin_amdgcn_mfma_f32_32x32x16_bf16((a), (b), (c), 0, 0, 0)
DI s16x4 vtr(const LAS unsigned char* p) { return __builtin_bit_cast(s16x4, __builtin_amdgcn_ds_read_tr16_b64_v4i16((LAS s16x4*)p)); }
DI bf16x8 packp(const f32x16& x, int s) { u32x4 w; w.x = cvt_pk_bf16(x[8 * s], x[8 * s + 1]); w.y = cvt_pk_bf16(x[8 * s + 2], x[8 * s + 3]); w.z = cvt_pk_bf16(x[8 * s + 4], x[8 * s + 5]); w.w = cvt_pk_bf16(x[8 * s + 6], x[8 * s + 7]); return __builtin_bit_cast(bf16x8, w); }

template <bool DIFF>
DI void attn_unit(const bf16_t* Q, const bf16_t* __restrict__ K, const bf16_t* __restrict__ V, bf16_t* O, int b, int h, int qb, LAS unsigned char* lds, float lam, const float* subg) {
    constexpr int DQK = DIFF ? 64 : 96, DV = DIFF ? 128 : 64, NKS = DQK / 16, NDB = DV / 32;
    constexpr int KPITCH = DQK * 2 + 16, VPITCH = DV * 2 + 64, KT = 64 * KPITCH, VT = 64 * VPITCH, NK = DIFF ? 2 : 1, BUF = NK * KT + VT;
    constexpr int ROWS = DIFF ? 128 : 256, QP = DIFF ? 1024 : 768, VP = DIFF ? 1024 : 512, NST = DIFF ? 4 : 3;
    const int tid = threadIdx.x, lane = tid & 63, r = lane & 31, hh = lane >> 5;
    const int wid = __builtin_amdgcn_readfirstlane(tid >> 6);
    const int wrow = DIFF ? (wid & 3) : wid, map = DIFF ? (wid >> 2) : 0;
    const int q0 = qb * ROWS, qw0 = q0 + 32 * wrow;
    const size_t rowbase = (size_t)b * SEQ;
    bf16x8 qf[NKS];
    { const bf16_t* Qp = Q + (rowbase + qw0 + r) * QP + (DIFF ? (2 * h + map) * 64 : h * 96) + hh * 8;
#pragma unroll
      for (int ks = 0; ks < NKS; ++ks) qf[ks] = *(const bf16x8*)(Qp + ks * 16); }
    const bf16_t* src[NST]; unsigned dst[NST]; size_t tstep[NST]; bool ok1 = true;
    if (DIFF) {
        const int kr = tid >> 3, kc = tid & 7;
        src[0] = K + (rowbase + kr) * 1024 + (2 * h) * 64 + kc * 8; src[1] = src[0] + 64; dst[0] = kr * KPITCH + kc * 16; dst[1] = KT + dst[0];
        const int vr = tid >> 4, vc = tid & 15;
        src[2] = V + (rowbase + vr) * 1024 + h * 128 + vc * 8; src[3] = src[2] + 32 * 1024; dst[2] = 2 * KT + vr * VPITCH + vc * 16; dst[3] = dst[2] + 32 * VPITCH;
        tstep[0] = tstep[1] = tstep[2] = tstep[3] = (size_t)64 * 1024;
    } else {
        const int r0 = tid / 12, c0 = tid % 12, id1 = tid + 512, r1 = id1 / 12, c1 = id1 % 12; ok1 = tid < 256;
        src[0] = K + (rowbase + r0) * 768 + h * 96 + c0 * 8; dst[0] = r0 * KPITCH + c0 * 16;
        src[1] = K + (rowbase + (ok1 ? r1 : 0)) * 768 + h * 96 + c1 * 8; dst[1] = r1 * KPITCH + c1 * 16;
        const int vr = tid >> 3, vc = tid & 7;
        src[2] = V + (rowbase + vr) * 512 + h * 64 + vc * 8; dst[2] = KT + vr * VPITCH + vc * 16;
        tstep[0] = tstep[1] = (size_t)64 * 768; tstep[2] = (size_t)64 * 512;
    }
    u32x4 st[NST];
#define ATT_LOAD(t) do { _Pragma("unroll") for (int i_ = 0; i_ < NST; ++i_) if (i_ != 1 || ok1) st[i_] = *(const u32x4*)(src[i_] + (size_t)(t) * tstep[i_]); } while (0)
#define ATT_STORE(bufp) do { _Pragma("unroll") for (int i_ = 0; i_ < NST; ++i_) if (i_ != 1 || ok1) *(LAS u32x4*)((bufp) + dst[i_]) = st[i_]; } while (0)
    f32x16 o[NDB];
#pragma unroll
    for (int db = 0; db < NDB; ++db)
#pragma unroll
        for (int i = 0; i < 16; ++i) o[db][i] = 0.f;
    float m_run = -INFINITY, l_run = 0.f;
    const int nt = (q0 + ROWS) / 64;
    const int i16 = lane & 15, q4 = i16 >> 2, pp = i16 & 3, g1 = (lane >> 4) & 1;
    ATT_LOAD(0); ATT_STORE(lds); __syncthreads();
    for (int t = 0; t < nt; ++t) {
        const bool more = t + 1 < nt;
        if (more) ATT_LOAD(t + 1);
        LAS unsigned char* buf = lds + (t & 1) * BUF;
        if (64 * t <= qw0) {
            const LAS unsigned char* Kb = buf + (DIFF ? map * KT : 0) + r * KPITCH + hh * 16;
            f32x16 x0, x1;
#pragma unroll
            for (int i = 0; i < 16; ++i) { x0[i] = 0.f; x1[i] = 0.f; }
#pragma unroll
            for (int ks = 0; ks < NKS; ++ks) {
                const bf16x8 a0 = *(const LAS bf16x8*)(Kb + ks * 32), a1 = *(const LAS bf16x8*)(Kb + 32 * KPITCH + ks * 32);
                x0 = MFMA32(a0, qf[ks], x0); x1 = MFMA32(a1, qf[ks], x1);
            }
            if (64 * t + 63 > qw0) {
                const int qi = qw0 + r, kb0 = 64 * t + 4 * hh;
#pragma unroll
                for (int i = 0; i < 16; ++i) { const int key = kb0 + (i & 3) + 8 * (i >> 2); if (key > qi) x0[i] = -INFINITY; if (key + 32 > qi) x1[i] = -INFINITY; }
            }
            float mx = fmaxf(x0[0], x1[0]);
#pragma unroll
            for (int i = 1; i < 16; ++i) mx = fmaxf(mx, fmaxf(x0[i], x1[i]));
            mx = fmaxf(mx, __shfl_xor(mx, 32));
            const float m_new = fmaxf(m_run, mx), alpha = __builtin_amdgcn_exp2f(m_run - m_new); m_run = m_new;
            float ps = 0.f;
#pragma unroll
            for (int i = 0; i < 16; ++i) { x0[i] = __builtin_amdgcn_exp2f(x0[i] - m_new); x1[i] = __builtin_amdgcn_exp2f(x1[i] - m_new); ps += x0[i] + x1[i]; }
            l_run = l_run * alpha + ps;
#pragma unroll
            for (int db = 0; db < NDB; ++db)
#pragma unroll
                for (int i = 0; i < 16; ++i) o[db][i] *= alpha;
            bf16x8 pk[2][2]; pk[0][0] = packp(x0, 0); pk[0][1] = packp(x0, 1); pk[1][0] = packp(x1, 0); pk[1][1] = packp(x1, 1);
            const LAS unsigned char* Vb = buf + NK * KT + (4 * hh + q4) * VPITCH + (16 * g1 + 4 * pp) * 2;
#pragma unroll
            for (int db = 0; db < NDB; ++db)
#pragma unroll
                for (int kb = 0; kb < 2; ++kb)
#pragma unroll
                    for (int s = 0; s < 2; ++s) {
                        const LAS unsigned char* vp = Vb + (32 * kb + 16 * s) * VPITCH + db * 64;
                        const s16x4 lo = vtr(vp), hi = vtr(vp + 8 * VPITCH);
                        const bf16x8 vf = __builtin_shufflevector(lo, hi, 0, 1, 2, 3, 4, 5, 6, 7);
                        o[db] = MFMA32(vf, pk[kb][s], o[db]);
                    }
        }
        if (more) ATT_STORE(lds + ((t + 1) & 1) * BUF);
        __syncthreads();
    }
#undef ATT_LOAD
#undef ATT_STORE
    const float l = l_run + __shfl_xor(l_run, 32), inv = 1.0f / l;
    if (DIFF) {
        LAS float* scr = (LAS float*)lds + wrow * 4096;
        if (map == 1) { const float f = lam * inv;
#pragma unroll
            for (int db = 0; db < NDB; ++db)
#pragma unroll
                for (int i = 0; i < 16; ++i) scr[(db * 16 + i) * 64 + lane] = o[db][i] * f; }
        __syncthreads();
        if (map == 0) { float ss = 0.f;
#pragma unroll
            for (int db = 0; db < NDB; ++db)
#pragma unroll
                for (int i = 0; i < 16; ++i) { const float v = o[db][i] * inv - scr[(db * 16 + i) * 64 + lane]; o[db][i] = v; ss += v * v; }
            ss += __shfl_xor(ss, 32);
            const float rs = rsqrtf(ss * (1.f / 128.f) + EPS) * 0.8f;
            bf16_t* op = O + (rowbase + qw0 + r) * 1024 + h * 128 + 4 * hh;
#pragma unroll
            for (int db = 0; db < NDB; ++db)
#pragma unroll
                for (int g = 0; g < 4; ++g) { const int d = 32 * db + 8 * g; const f32x4 gg = *(const f32x4*)(subg + d + 4 * hh);
                    const f32x4 v = {o[db][4 * g] * rs * gg[0], o[db][4 * g + 1] * rs * gg[1], o[db][4 * g + 2] * rs * gg[2], o[db][4 * g + 3] * rs * gg[3]};
                    *(u32x2*)(op + d) = pack4(v); } }
        __syncthreads();
    } else {
        bf16_t* op = O + (rowbase + qw0 + r) * 512 + h * 64 + 4 * hh;
#pragma unroll
        for (int db = 0; db < NDB; ++db)
#pragma unroll
            for (int g = 0; g < 4; ++g) { const f32x4 v = {o[db][4 * g] * inv, o[db][4 * g + 1] * inv, o[db][4 * g + 2] * inv, o[db][4 * g + 3] * inv};
                *(u32x2*)(op + 32 * db + 8 * g) = pack4(v); }
    }
}
}

struct Args { const float* in[20]; float* out; unsigned char* ws; int ph_lo, ph_hi; };
__global__ void __launch_bounds__(512, 2) fwd_megakernel(Args args) {
    extern __shared__ __attribute__((aligned(16))) unsigned char lds_raw[];
    LAS unsigned char* lds = (LAS unsigned char*)lds_raw;
    const int tid = threadIdx.x, lane = tid & 63, wave = __builtin_amdgcn_readfirstlane(tid >> 6);
    const int G = gridDim.x, bx = blockIdx.x;
    const int vcu = (G % 8 == 0) ? (bx % 8) * (G / 8) + bx / 8 : bx;
    unsigned char* ws = args.ws;
    const float* x = args.in[0];
    bf16_t *Win_t = (bf16_t*)(ws + WS_WIN), *Wup_t = (bf16_t*)(ws + WS_WUP), *Wdown_t = (bf16_t*)(ws + WS_WDOWN), *Wbrd_t = (bf16_t*)(ws + WS_WBRD), *Wout_t = (bf16_t*)(ws + WS_WOUT),
           *Wbrm_t = (bf16_t*)(ws + WS_WBRM), *Wqb_t = (bf16_t*)(ws + WS_WQB), *Wkvb_t = (bf16_t*)(ws + WS_WKVB);
    bf16_t *QD = (bf16_t*)(ws + WS_QD), *KD = (bf16_t*)(ws + WS_KD), *VD = (bf16_t*)(ws + WS_VD), *QM = (bf16_t*)(ws + WS_QM), *KM = (bf16_t*)(ws + WS_KM), *VM = (bf16_t*)(ws + WS_VM),
           *QA = (bf16_t*)(ws + WS_QA), *CKV = (bf16_t*)(ws + WS_CKV), *XN = (bf16_t*)(ws + WS_XN), *OM = (bf16_t*)(ws + WS_OM), *MIX = (bf16_t*)(ws + WS_MIX), *HB = (bf16_t*)(ws + WS_H);
    bf16_t* GB = (bf16_t*)args.out;
    float *Tb = (float*)(ws + WS_T), *Yb = (float*)(ws + WS_Y), *Mo = (float*)(ws + WS_MO);
    float *ssq = (float*)(ws + WS_CTL + CT_SSQ), *sskv = (float*)(ws + WS_CTL + CT_SSKV), *ssy = (float*)(ws + WS_CTL + CT_SSY), *ssm = (float*)(ws + WS_CTL + CT_SSM),
          *RD = (float*)(ws + WS_CTL + CT_RD), *RM = (float*)(ws + WS_CTL + CT_RM);
    const int lo = args.ph_lo, hi = args.ph_hi;
#define IN(k) (lo <= (k) && (k) < hi)
#if MK_N_LAUNCHES == 1
#define SEAM(k) do { if (IN(k) && IN((k) + 1)) cg::this_grid().sync(); } while (0)
#else
#define SEAM(k) do { } while (0)
#endif
    const int gw = vcu * 8 + wave, NGW = G * 8;

    if (IN(0)) {
        LAS float* scr = (LAS float*)(lds + wave * 16384);
        constexpr int I_IN = 16 * (NPROJ / 32), I_QB = 4 * 24, I_KVB = 2 * 32, I_BRM = 8 * 32, I_BRD = 16 * 32, I_OUT = 16 * 32, I_UP = 16 * 128, I_DN = 64 * 32;
        constexpr int NITEMS = I_IN + I_QB + I_KVB + I_BRM + I_BRD + I_OUT + I_UP + I_DN;
        for (int it = gw; it < NITEMS; it += NGW) {
            int r = it;
            if (r < I_IN) { transpose_item<1>(args.in[2], 1024, 5536, NPROJ, Win_t, nullptr, scr, r, lane); continue; } r -= I_IN;
            if (r < I_QB) { transpose_item<2>(args.in[4], 256, 768, 768, Wqb_t, args.in[3], scr, r, lane); continue; } r -= I_QB;
            if (r < I_KVB) { transpose_item<0>(args.in[6], 128, 1024, 1024, Wkvb_t, args.in[5], scr, r, lane); continue; } r -= I_KVB;
            if (r < I_BRM) { transpose_item<0>(args.in[12], 512, 1024, 1024, Wbrm_t, nullptr, scr, r, lane); continue; } r -= I_BRM;
            if (r < I_BRD) { transpose_item<0>(args.in[13], 1024, 1024, 1024, Wbrd_t, nullptr, scr, r, lane); continue; } r -= I_BRD;
            if (r < I_OUT) { transpose_item<0>(args.in[14], 1024, 1024, 1024, Wout_t, nullptr, scr, r, lane); continue; } r -= I_OUT;
            if (r < I_UP) { transpose_item<0>(args.in[17], 1024, 4096, 4096, Wup_t, nullptr, scr, r, lane); continue; } r -= I_UP;
            transpose_item<0>(args.in[18], 4096, 1024, 1024, Wdown_t, nullptr, scr, r, lane);
        }
        for (int e = vcu * 512 + tid; e < SEQ * 48; e += G * 512) {
            if (e < SEQ * 32) rope_entry(RD + 2 * e, e >> 5, (float)(e & 31) * (1.f / 32.f));
            else { const int e2 = e - SEQ * 32; rope_entry(RM + 2 * e2, e2 >> 4, (float)(e2 & 15) * (1.f / 16.f)); }
        }
        for (int m = gw; m < M; m += NGW) rms_row_to_bf16(x + (size_t)m * DM, args.in[1], XN + (size_t)m * DM, lane);
    }
    SEAM(0);
    if (IN(1)) {
        pg8::Gemm g{XN, Win_t, M, NPROJ, DM}; pg8::StaticOrder S; S.init(M, NPROJ, G, bx);
        EpiProj E{QA, CKV, KM, QD, KD, VD, GB, ssq, sskv, RD, RM};
        pg8::gemm_phase<EpiProj, pg8::StaticOrder, true, true>(lds, g, S, E);
    }
    SEAM(1);
    if (IN(2)) {
        { int kq = 256; asm volatile("" : "+s"(kq)); pg8::Gemm g{QA, Wqb_t, M, 768, kq}; pg8::StaticOrder S; S.init(M, 768, G, bx); EpiQ E{ssq, QM, RM};
          pg8::gemm_phase<EpiQ, pg8::StaticOrder, true, true>(lds, g, S, E); }
        { int kk = 128; asm volatile("" : "+s"(kk)); pg8::Gemm g{CKV, Wkvb_t, M, 1024, kk}; pg8::StaticOrder S; S.init(M, 1024, G, (bx + 192) % G); EpiKV E{sskv, KM, VM};
          pg8::gemm_phase<EpiKV, pg8::StaticOrder, true, true>(lds, g, S, E); }
    }
    SEAM(2);
    if (IN(3)) {
        float lam;
        { const float a = args.in[7][lane] * args.in[8][lane], b = args.in[9][lane] * args.in[10][lane];
          lam = __builtin_amdgcn_exp2f(wave_sum(a) * LOG2E) - __builtin_amdgcn_exp2f(wave_sum(b) * LOG2E) + 0.2f; }
        for (int v = vcu; v < 256; v += G) {
            const int bh = v >> 2, pr = v & 3, b = bh >> 3, h = bh & 7;
            att::attn_unit<false>(QM, KM, VM, OM, b, h, 7 - pr, lds, 0.f, nullptr);
            att::attn_unit<false>(QM, KM, VM, OM, b, h, pr, lds, 0.f, nullptr);
#pragma unroll 1
            for (int k = 0; k < 4; ++k) { const int p0 = 2 * pr + (k >> 1), qb = (k & 1) ? p0 : 15 - p0;
                att::attn_unit<true>(QD, KD, VD, QD, b, h, qb, lds, lam, args.in[11]); }
        }
    }
    SEAM(3);
    if (IN(4)) {
        { pg8::Gemm g{OM, Wbrm_t, M, DM, 512}; pg8::StaticOrder S; S.init(M, DM, G, bx); EpiBr1 E{GB, Tb};
          pg8::gemm_phase<EpiBr1, pg8::StaticOrder, true, true>(lds, g, S, E); }
        { pg8::Gemm g{QD, Wbrd_t, M, DM, DM}; pg8::StaticOrder S; S.init(M, DM, G, bx); EpiBr2 E{GB, Tb, MIX};
          pg8::gemm_phase<EpiBr2, pg8::StaticOrder, true, true>(lds, g, S, E); }
    }
    SEAM(4);
    if (IN(5)) {
        pg8::Gemm g{MIX, Wout_t, M, DM, DM}; pg8::StaticOrder S; S.init(M, DM, G, bx); EpiF32SS E{Yb, ssy};
        pg8::gemm_phase<EpiF32SS, pg8::StaticOrder, true, true>(lds, g, S, E);
    }
    SEAM(5);
    if (IN(6)) {
        const f32x4* g1 = (const f32x4*)args.in[15] + lane; const f32x4* g2 = (const f32x4*)args.in[16] + lane;
        for (int m = gw; m < M; m += NGW) {
            const f32x4* yr = (const f32x4*)(Yb + (size_t)m * DM) + lane; const f32x4* xr = (const f32x4*)(x + (size_t)m * DM) + lane;
            const f32x4* sp = (const f32x4*)(ssy + m * 16); const f32x4 sa = sp[0] + sp[1] + sp[2] + sp[3];
            const float rs1 = rsqrtf(((sa[0] + sa[1]) + (sa[2] + sa[3])) * (1.f / DM) + EPS);
            f32x4 v[4]; float s = 0.f;
#pragma unroll
            for (int j = 0; j < 4; ++j) { v[j] = xr[64 * j] + yr[64 * j] * rs1 * g1[64 * j]; s += sumsq4(v[j]); }
            f32x4* orow = (f32x4*)(args.out + (size_t)m * DM) + lane;
#pragma unroll
            for (int j = 0; j < 4; ++j) orow[64 * j] = v[j];
            const float rs2 = rsqrtf(wave_sum(s) * (1.f / DM) + EPS);
            u32x2* o8 = (u32x2*)(XN + (size_t)m * DM) + lane;
#pragma unroll
            for (int j = 0; j < 4; ++j) o8[64 * j] = pack4(v[j] * rs2 * g2[64 * j]);
        }
    }
    SEAM(6);
    if (IN(7)) {
        pg8::Gemm g{XN, Wup_t, M, FF, DM}; pg8::StaticOrder S; S.init(M, FF, G, bx); EpiUp E{HB};
        pg8::gemm_phase<EpiUp, pg8::StaticOrder, true, true>(lds, g, S, E);
    }
    SEAM(7);
    if (IN(8)) {
        pg8::Gemm g{HB, Wdown_t, M, DM, FF}; pg8::StaticOrder S; S.init(M, DM, G, bx); EpiF32SS E{Mo, ssm};
        pg8::gemm_phase<EpiF32SS, pg8::StaticOrder, true, true>(lds, g, S, E);
    }
    SEAM(8);
    if (IN(9)) {
        const f32x4* g3 = (const f32x4*)args.in[19] + lane;
        for (int m = gw; m < M; m += NGW) {
            const f32x4* mr = (const f32x4*)(Mo + (size_t)m * DM) + lane; f32x4* orow = (f32x4*)(args.out + (size_t)m * DM) + lane;
            const f32x4* sp = (const f32x4*)(ssm + m * 16); const f32x4 sa = sp[0] + sp[1] + sp[2] + sp[3];
            const float rs = rsqrtf(((sa[0] + sa[1]) + (sa[2] + sa[3])) * (1.f / DM) + EPS);
#pragma unroll
            for (int j = 0; j < 4; ++j) orow[64 * j] = orow[64 * j] + mr[64 * j] * rs * g3[64 * j];
        }
    }
#undef IN
#undef SEAM
}

extern "C" void kernel_launch(void* const* d_in, const int* in_sizes, int n_in, void* d_out, int out_size, void* d_ws, size_t ws_size, hipStream_t stream) {
    static int grid = 0;
    if (grid == 0) {
        if (n_in != 20 || out_size != M * DM || ws_size < 244 * MiB) { fprintf(stderr, "kernel_launch: unexpected problem (n_in %d, out %d, ws %zu)\n", n_in, out_size, ws_size); grid = -1; return; }
        if (hipFuncSetAttribute((const void*)fwd_megakernel, hipFuncAttributeMaxDynamicSharedMemorySize, LDS_BYTES) != hipSuccess) { fprintf(stderr, "kernel_launch: hipFuncSetAttribute failed\n"); grid = -1; return; }
        int dev = 0, cus = 0, per_cu = 0;
        (void)hipGetDevice(&dev); (void)hipDeviceGetAttribute(&cus, hipDeviceAttributeMultiprocessorCount, dev);
        (void)hipOccupancyMaxActiveBlocksPerMultiprocessor(&per_cu, (const void*)fwd_megakernel, 512, LDS_BYTES);
        (void)hipGetLastError();
        grid = cus * (per_cu > 0 ? per_cu : 1); if (grid > 256) grid = 256; if (grid < 8) grid = 8;
    }
    if (grid < 0) return;
    Args a{};
    for (int i = 0; i < 20; ++i) a.in[i] = (const float*)d_in[i];
    a.out = (float*)d_out; a.ws = (unsigned char*)d_ws;
#if MK_N_LAUNCHES == 1
    a.ph_lo = 0; a.ph_hi = NPH;
    void* kargs[] = {&a};
    hipError_t e = hipLaunchCooperativeKernel((const void*)fwd_megakernel, dim3(grid), dim3(512), kargs, LDS_BYTES, stream);
    if (e != hipSuccess) fprintf(stderr, "kernel_launch: cooperative launch failed: %s (grid %d)\n", hipGetErrorString(e), grid);
#else
    for (int ph = 0; ph < NPH; ++ph) { a.ph_lo = ph; a.ph_hi = ph + 1; hipLaunchKernelGGL(fwd_megakernel, dim3(grid), dim3(512), LDS_BYTES, stream, a); }
#endif
}
```

```cpp
#include <hip/hip_runtime.h>
#include <hip/hip_cooperative_groups.h>
#include <cstdio>
#include <cstdint>
namespace cg = cooperative_groups;
#define MK_N_LAUNCHES 1
namespace pg8 {
#define PG8_LAS __attribute__((address_space(3)))
typedef unsigned short bf16_t;
typedef short bf16x8 __attribute__((ext_vector_type(8)));
typedef float f32x4 __attribute__((ext_vector_type(4)));
typedef unsigned u32x4 __attribute__((ext_vector_type(4)));
constexpr int BM = 256, BK = 64, HALF = 128, HTB = HALF * BK * 2  , STAGE_BYTES = 8 * HTB, NXCD = 8, WGM = 8;

__host__ __device__ __forceinline__ int lds_byte(int r, int c) { const int st = (r >> 4) * 2 + (c >> 5), rr = r & 15, cc = c & 31, ob = rr * 64 + cc * 2; return st * 1024 + (ob ^ (((ob >> 9) & 1) << 5)); }
__host__ __device__ __forceinline__ void stage_rc(int b, int& R, int& C) { const int st = b / 1024, sb = b % 1024, swz = sb ^ (((sb >> 9) & 1) << 5); R = (st >> 1) * 16 + swz / 64; C = (st & 1) * 32 + (swz % 64) / 2; }
__host__ __device__ __forceinline__ int perm32(int rho) { const int n = rho >> 4, i = rho & 15; return 8 * (i >> 2) + 4 * n + (i & 3); }

struct Unit { int pm, pn; };
struct Gemm { const bf16_t* A; const bf16_t* Bt; int M, N, K; };

struct StaticOrder {
    int nM, nN, nwg, G, c;
    __host__ __device__ void init(int M, int N, int G_, int c_) { nM = M / BM; nN = N / BM; nwg = nM * nN; G = G_; c = c_; }
    __host__ __device__ bool next(int i, Unit& u) const {
        const long L = (long)i * G + c; if (L >= nwg) return false;
        int wgid = (int)L; { const int q = nwg / NXCD, r = nwg % NXCD, xcd = wgid % NXCD, off = wgid / NXCD; wgid = (xcd < r ? xcd * (q + 1) : r * (q + 1) + (xcd - r) * q) + off; }
        const int nig = WGM * nN, gid = wgid / nig, fm = gid * WGM, gsz = (nM - fm) < WGM ? (nM - fm) : WGM;
        u.pm = fm + ((wgid % nig) % gsz); u.pn = (wgid % nig) / gsz; return true;
    }
    __device__ __forceinline__ void a_ready(const Unit&) const {}
    __device__ __forceinline__ void done(const Unit&) const {}
};

__device__ __forceinline__ unsigned cvt_pk_bf16(float lo, float hi) { unsigned r; asm volatile("v_cvt_pk_bf16_f32 %0, %1, %2" : "=v"(r) : "v"(lo), "v"(hi)); return r; }
typedef float f32x2 __attribute__((ext_vector_type(2)));
template <class Epi, class Sched, bool ALIGN_EPI = false, bool SP2 = false>
__device__ __forceinline__ void gemm_phase(PG8_LAS unsigned char* lds, const Gemm g, const Sched& S, const Epi& E) {
    const int tid = threadIdx.x, wid = __builtin_amdgcn_readfirstlane(tid >> 6), lane = tid & 63, wr = wid >> 2, wc = wid & 3, fr = lane & 15, fq = lane >> 4;
    const int K = g.K, nt = K / BK;
    unsigned voffA[2], voffB[2];
#pragma unroll
    for (int i = 0; i < 2; ++i) { int R, C; stage_rc(tid * 16 + i * 8192, R, C); const int Rb = Epi::PERM ? ((R & ~31) + perm32(R & 31)) : R;
        voffA[i] = (unsigned)(R * K + C) * 2u; voffB[i] = (unsigned)(Rb * K + C) * 2u; }
    const size_t kstep = (size_t)(BK * 2);
    const size_t hstep = (size_t)HALF * K * 2;
    const size_t tstep = 2 * hstep;
    const unsigned ldsw = (unsigned)wid * 1024u;
    const int aoff = lds_byte(wr * 64 + fr, fq * 8), boff = lds_byte(wc * 32 + fr, fq * 8);
#define PG8_SA(b, h) (((b) * 2 + (h)) * HTB)
#define PG8_SB(b, h) ((4 + (b) * 2 + (h)) * HTB)
#define PG8_STAGE(bufoff, gbase, voff) do { _Pragma("unroll") for (int _i = 0; _i < 2; ++_i) \
        __builtin_amdgcn_global_load_lds((const unsigned*)((const char*)(gbase) + (voff)[_i]), (PG8_LAS unsigned*)(lds + (bufoff) + ldsw + _i * 8192), 16, 0, 0); } while (0)
#define PG8_LDA(dst, b, h) do { _Pragma("unroll") for (int m = 0; m < 4; ++m) _Pragma("unroll") for (int k = 0; k < 2; ++k) dst[m][k] = *(const PG8_LAS bf16x8*)(lds + PG8_SA(b, h) + aoff + m * 2048 + k * 1024); } while (0)
#define PG8_LDB(dst, b, h) do { _Pragma("unroll") for (int n = 0; n < 2; ++n) _Pragma("unroll") for (int k = 0; k < 2; ++k) dst[n][k] = *(const PG8_LAS bf16x8*)(lds + PG8_SB(b, h) + boff + n * 2048 + k * 1024); } while (0)
#define PG8_MMA(ai, bj, At, Bt) do { __builtin_amdgcn_s_setprio(1); _Pragma("unroll") for (int m = 0; m < 4; ++m) _Pragma("unroll") for (int n = 0; n < 2; ++n) _Pragma("unroll") for (int k = 0; k < 2; ++k) \
        acc[ai][bj][m][n] = __builtin_amdgcn_mfma_f32_16x16x32_bf16(Bt[n][k], At[m][k], acc[ai][bj][m][n], 0, 0, 0); __builtin_amdgcn_s_setprio(0); } while (0)
#define PG8_WAIT_V(n) asm volatile("s_waitcnt vmcnt(" #n ")" ::: "memory")
#define PG8_WAIT_L(n) asm volatile("s_waitcnt lgkmcnt(" #n ")" ::: "memory")
#define PG8_BAR __builtin_amdgcn_s_barrier()
#define PG8_SCHED __builtin_amdgcn_sched_barrier(0)
    Unit cur, nxt; int ui = 0;
    if (!S.next(0, cur)) return;
    f32x4 acc[2][2][4][2];
#pragma unroll
    for (int a = 0; a < 2; ++a)
#pragma unroll
        for (int b = 0; b < 2; ++b)
#pragma unroll
            for (int m = 0; m < 4; ++m)
#pragma unroll
                for (int n = 0; n < 2; ++n) acc[a][b][m][n] = (f32x4){0.f, 0.f, 0.f, 0.f};
    bf16x8 At[4][2], B0[2][2], B1[2][2];
    const char* cA = (const char*)g.A + (size_t)cur.pm * tstep; const char* cB = (const char*)g.Bt + (size_t)cur.pn * tstep;
    S.a_ready(cur);
    if constexpr (SP2) {
        PG8_STAGE(PG8_SB(0, 0), cB, voffB); PG8_STAGE(PG8_SB(0, 1), cB + hstep, voffB); PG8_STAGE(PG8_SA(0, 0), cA, voffA); PG8_STAGE(PG8_SA(0, 1), cA + hstep, voffA);
        if (wr == 1) PG8_BAR;
        PG8_WAIT_V(2); PG8_BAR;
        PG8_STAGE(PG8_SB(1, 0), cB + kstep, voffB); PG8_STAGE(PG8_SA(1, 0), cA + kstep, voffA); PG8_STAGE(PG8_SB(1, 1), cB + hstep + kstep, voffB);
        PG8_WAIT_V(6); PG8_BAR;
    } else {
        PG8_STAGE(PG8_SB(0, 0), cB, voffB); PG8_STAGE(PG8_SA(0, 0), cA, voffA); PG8_STAGE(PG8_SB(0, 1), cB + hstep, voffB); PG8_STAGE(PG8_SA(0, 1), cA + hstep, voffA);
        if (wr == 1) PG8_BAR;
        PG8_WAIT_V(4); PG8_BAR;
        PG8_STAGE(PG8_SB(1, 0), cB + kstep, voffB); PG8_STAGE(PG8_SA(1, 0), cA + kstep, voffA); PG8_STAGE(PG8_SB(1, 1), cB + hstep + kstep, voffB);
        PG8_WAIT_V(6); PG8_BAR;
    }
    for (;;) {
        const bool has_next = S.next(ui + 1, nxt);
        const char* nA = has_next ? (const char*)g.A + (size_t)nxt.pm * tstep : cA; const char* nB = has_next ? (const char*)g.Bt + (size_t)nxt.pn * tstep : cB;
        for (int t = 0; t < nt; t += 2) {
            const bool last = (t == nt - 2);
            const char* a1 = cA + (size_t)(t + 1) * kstep;
            const char* a2 = last ? nA : cA + (size_t)(t + 2) * kstep; const char* b2 = last ? nB : cB + (size_t)(t + 2) * kstep;
            const char* a3 = a2 + kstep; const char* b3 = b2 + kstep;
            if (last && has_next) S.a_ready(nxt);
            if constexpr (SP2) {
            PG8_LDB(B0, 0, 0); PG8_LDB(B1, 0, 1); PG8_SCHED; PG8_LDA(At, 0, 0); PG8_STAGE(PG8_SA(1, 1), a1 + hstep, voffA);
            PG8_WAIT_V(8); PG8_WAIT_L(0); PG8_BAR; PG8_MMA(0, 0, At, B0); PG8_MMA(0, 1, At, B1); PG8_BAR; PG8_SCHED;
            PG8_LDA(At, 0, 1); PG8_STAGE(PG8_SB(0, 0), b2, voffB); PG8_STAGE(PG8_SB(0, 1), b2 + hstep, voffB); PG8_STAGE(PG8_SA(0, 0), a2, voffA);
            PG8_WAIT_V(8); PG8_WAIT_L(0); PG8_BAR; PG8_MMA(1, 0, At, B0); PG8_MMA(1, 1, At, B1); PG8_BAR; PG8_SCHED;
            PG8_LDB(B0, 1, 0); PG8_LDB(B1, 1, 1); PG8_SCHED; PG8_LDA(At, 1, 0); PG8_STAGE(PG8_SA(0, 1), a2 + hstep, voffA);
            PG8_WAIT_V(8); PG8_WAIT_L(0); PG8_BAR; PG8_MMA(0, 0, At, B0); PG8_MMA(0, 1, At, B1); PG8_BAR; PG8_SCHED;
            PG8_LDA(At, 1, 1); PG8_STAGE(PG8_SB(1, 0), b3, voffB); PG8_STAGE(PG8_SB(1, 1), b3 + hstep, voffB); PG8_STAGE(PG8_SA(1, 0), a3, voffA);
            PG8_WAIT_V(8); PG8_WAIT_L(0); PG8_BAR; PG8_MMA(1, 0, At, B0); PG8_MMA(1, 1, At, B1); PG8_BAR; PG8_SCHED;
            } else {
            PG8_LDB(B0, 0, 0); PG8_SCHED; PG8_LDA(At, 0, 0); PG8_STAGE(PG8_SA(1, 1), a1 + hstep, voffA);
            PG8_WAIT_L(8); PG8_BAR; PG8_WAIT_L(0); PG8_MMA(0, 0, At, B0); PG8_BAR; PG8_SCHED;
            PG8_LDB(B1, 0, 1); PG8_STAGE(PG8_SB(0, 0), b2, voffB);
            PG8_BAR; PG8_WAIT_L(0); PG8_MMA(0, 1, At, B1); PG8_BAR;
            PG8_LDA(At, 0, 1); PG8_STAGE(PG8_SA(0, 0), a2, voffA);
            PG8_BAR; PG8_WAIT_L(0); PG8_MMA(1, 0, At, B0); PG8_BAR; PG8_SCHED;
            PG8_STAGE(PG8_SB(0, 1), b2 + hstep, voffB);
            PG8_WAIT_V(6); PG8_BAR; PG8_MMA(1, 1, At, B1); PG8_BAR;
            PG8_LDB(B0, 1, 0); PG8_SCHED; PG8_LDA(At, 1, 0); PG8_STAGE(PG8_SA(0, 1), a2 + hstep, voffA);
            PG8_WAIT_L(8); PG8_BAR; PG8_WAIT_L(0); PG8_MMA(0, 0, At, B0); PG8_BAR; PG8_SCHED;
            PG8_LDB(B1, 1, 1); PG8_STAGE(PG8_SB(1, 0), b3, voffB);
            PG8_BAR; PG8_WAIT_L(0); PG8_MMA(0, 1, At, B1); PG8_BAR;
            PG8_LDA(At, 1, 1); PG8_STAGE(PG8_SA(1, 0), a3, voffA);
            PG8_BAR; PG8_WAIT_L(0); PG8_MMA(1, 0, At, B0); PG8_BAR; PG8_SCHED;
            PG8_STAGE(PG8_SB(1, 1), b3 + hstep, voffB);
            PG8_WAIT_V(6); PG8_BAR; PG8_MMA(1, 1, At, B1); PG8_BAR;
            }
        }
        if constexpr (ALIGN_EPI) { if (wr == 0) PG8_BAR; }
        if constexpr (!Epi::AFTER_DRAIN) { E(acc, cur, wr, wc, fr, fq); S.done(cur); }
        if (!has_next) break;
#pragma unroll
        for (int a = 0; a < 2; ++a)
#pragma unroll
            for (int b = 0; b < 2; ++b)
#pragma unroll
                for (int m = 0; m < 4; ++m)
#pragma unroll
                    for (int n = 0; n < 2; ++n) acc[a][b][m][n] = (f32x4){0.f, 0.f, 0.f, 0.f};
        cur = nxt; cA = nA; cB = nB; ++ui;
        if constexpr (ALIGN_EPI) { if (wr == 1) PG8_BAR; }
    }
    PG8_WAIT_V(0);
    if constexpr (!ALIGN_EPI) { if (wr == 0) PG8_BAR; }
    PG8_BAR;
    if constexpr (Epi::AFTER_DRAIN) { E.fused(acc, cur, wr, wc, fr, fq, lds, wid, lane); S.done(cur); }
#undef PG8_SA
#undef PG8_SB
#undef PG8_STAGE
#undef PG8_LDA
#undef PG8_LDB
#undef PG8_MMA
#undef PG8_WAIT_V
#undef PG8_WAIT_L
#undef PG8_BAR
#undef PG8_SCHED
}
}

#ifndef MK_N_LAUNCHES
#define MK_N_LAUNCHES 1
#endif
#define DI __device__ __forceinline__
#define LAS __attribute__((address_space(3)))
constexpr int BATCH = 8, SEQ = 2048, DM = 1024, M = BATCH * SEQ, FF = 4096;
constexpr int NPROJ = 5632;
constexpr float EPS = 1e-6f, LOG2E = 1.4426950408889634f;
constexpr float QS_MLA = 0.10206207261596575f * LOG2E, QS_DIFF = 0.125f * LOG2E;
constexpr size_t MiB = 1u << 20;
constexpr size_t WS_WIN = 2 * MiB, WS_WUP = 13 * MiB, WS_WDOWN = 21 * MiB, WS_WBRD = 29 * MiB, WS_WOUT = 31 * MiB, WS_WBRM = 33 * MiB, WS_WQB = 34 * MiB, WS_WKVB = 34 * MiB + 512 * 1024;
constexpr size_t WS_QD = 36 * MiB, WS_KD = 68 * MiB, WS_VD = 100 * MiB, WS_QM = 132 * MiB, WS_KM = 156 * MiB, WS_VM = 180 * MiB, WS_QA = 196 * MiB, WS_CKV = 204 * MiB, WS_XN = 208 * MiB;
constexpr size_t WS_OM = WS_XN, WS_MIX = WS_KD, WS_T = WS_QM, WS_Y = WS_QM, WS_H = 36 * MiB, WS_MO = 164 * MiB, WS_CTL = 240 * MiB;
constexpr size_t CT_SSQ = 0, CT_SSKV = 256 * 1024, CT_SSY = 512 * 1024, CT_SSM = 1536 * 1024, CT_RD = 2560 * 1024, CT_RM = 3072 * 1024, CT_BAR = 3328 * 1024, BAR_BYTES = 16384;
constexpr int MISC_OFF = 131072 + 64;
constexpr int LDS_BYTES = 147456;
constexpr int NPH = 10;

using pg8::f32x4; using pg8::u32x4; using pg8::bf16_t; using pg8::Unit;
typedef float f32x2_t __attribute__((ext_vector_type(2))); typedef __bf16 bf16x2_t __attribute__((ext_vector_type(2)));
DI unsigned cvt_pk_bf16(float lo, float hi) { const f32x2_t v = {lo, hi}; const bf16x2_t b = __builtin_convertvector(v, bf16x2_t); return __builtin_bit_cast(unsigned, b); }
typedef unsigned u32x2 __attribute__((ext_vector_type(2)));

DI u32x4 pack8(f32x4 a, f32x4 b) { u32x4 w; w.x = cvt_pk_bf16(a[0], a[1]); w.y = cvt_pk_bf16(a[2], a[3]); w.z = cvt_pk_bf16(b[0], b[1]); w.w = cvt_pk_bf16(b[2], b[3]); return w; }
DI u32x2 pack4(f32x4 a) { u32x2 w; w.x = cvt_pk_bf16(a[0], a[1]); w.y = cvt_pk_bf16(a[2], a[3]); return w; }
DI float bf_lo(unsigned w) { return __uint_as_float(w << 16); }
DI float bf_hi(unsigned w) { return __uint_as_float(w & 0xffff0000u); }
DI float sumsq4(f32x4 a) { return (a[0] * a[0] + a[1] * a[1]) + (a[2] * a[2] + a[3] * a[3]); }
DI float wave_sum(float v) {
#pragma unroll
    for (int o = 1; o < 64; o <<= 1) v += __shfl_xor(v, o);
    return v;
}
DI void rope4(f32x4& a, f32x4& b, const float* tab) {
    const f32x4 t0 = *(const f32x4*)tab, t1 = *(const f32x4*)(tab + 4);
    const f32x4 c = {t0[0], t0[2], t1[0], t1[2]}, s = {t0[1], t0[3], t1[1], t1[3]};
    const f32x4 lo = a * c - b * s, hi = b * c + a * s; a = lo; b = hi;
}
DI f32x4 sig4(f32x4 v) { f32x4 o;
#pragma unroll
    for (int e = 0; e < 4; ++e) o[e] = __builtin_amdgcn_rcpf(1.0f + __builtin_amdgcn_exp2f(-v[e] * LOG2E));
    return o; }

#define ACC_ARG const f32x4 (&acc)[2][2][4][2]
#define FOR_AM _Pragma("unroll") for (int ai = 0; ai < 2; ++ai) _Pragma("unroll") for (int m = 0; m < 4; ++m)
struct EpiProj {
    static constexpr bool PERM = true, AFTER_DRAIN = false;
    bf16_t *QA, *CKV, *KM, *QD, *KD, *VD, *G; float *ssq, *sskv; const float *RD, *RM;
    DI void operator()(ACC_ARG, const Unit& u, int wr, int wc, int fr, int fq) const {
        asm volatile("" : "+v"(fr), "+v"(fq));
        const int pn = u.pn, rb = u.pm * 256 + wr * 64 + fr, cw = wc * 32 + fq * 8;
        if (pn == 0) {
            FOR_AM { const int row = rb + ai * 128 + m * 16; float s = 0.f;
#pragma unroll
                for (int bj = 0; bj < 2; ++bj) { const f32x4 v0 = acc[ai][bj][m][0], v1 = acc[ai][bj][m][1]; s += sumsq4(v0) + sumsq4(v1);
                    *(u32x4*)(QA + (size_t)row * 256 + bj * 128 + cw) = pack8(v0, v1); }
                s += __shfl_xor(s, 16); s += __shfl_xor(s, 32); if (fq == 0) ssq[row * 4 + wc] = s; }
        } else if (pn == 1) {
            FOR_AM { const int row = rb + ai * 128 + m * 16; const f32x4 v0 = acc[ai][0][m][0], v1 = acc[ai][0][m][1];
                float s = sumsq4(v0) + sumsq4(v1);
                *(u32x4*)(CKV + (size_t)row * 128 + cw) = pack8(v0, v1);
                s += __shfl_xor(s, 16); s += __shfl_xor(s, 32); if (fq == 0) sskv[row * 4 + wc] = s;
                if (wc == 0) { f32x4 a = acc[ai][1][m][0], b = acc[ai][1][m][1]; const int pos = row & (SEQ - 1);
                    rope4(a, b, RM + (pos * 16 + 4 * fq) * 2); const u32x2 lo = pack4(a), hi = pack4(b);
#pragma unroll
                    for (int h = 0; h < 8; ++h) { bf16_t* kp = KM + (size_t)row * 768 + h * 96 + 64 + 4 * fq; *(u32x2*)kp = lo; *(u32x2*)(kp + 16) = hi; } } }
        } else if (pn < 10) {
            const bool isq = pn < 6; bf16_t* dst = isq ? QD : KD; const int ct = (isq ? pn - 2 : pn - 6) * 256; const float sc = isq ? QS_DIFF : 1.f;
            const int g = 4 * (wc & 1) + fq;
            FOR_AM { const int row = rb + ai * 128 + m * 16, pos = row & (SEQ - 1);
#pragma unroll
                for (int bj = 0; bj < 2; ++bj) { f32x4 a = acc[ai][bj][m][0], b = acc[ai][bj][m][1]; rope4(a, b, RD + (pos * 32 + 4 * g) * 2); a = a * sc; b = b * sc;
                    bf16_t* p = dst + (size_t)row * 1024 + ct + (2 * bj + (wc >> 1)) * 64 + 4 * g; *(u32x2*)p = pack4(a); *(u32x2*)(p + 32) = pack4(b); } }
        } else if (pn < 14) {
            FOR_AM { const int row = rb + ai * 128 + m * 16;
#pragma unroll
                for (int bj = 0; bj < 2; ++bj) *(u32x4*)(VD + (size_t)row * 1024 + (pn - 10) * 256 + bj * 128 + cw) = pack8(acc[ai][bj][m][0], acc[ai][bj][m][1]); }
        } else {
            FOR_AM { const int row = rb + ai * 128 + m * 16;
#pragma unroll
                for (int bj = 0; bj < 2; ++bj) *(u32x4*)(G + (size_t)row * 2048 + (pn - 14) * 256 + bj * 128 + cw) = pack8(sig4(acc[ai][bj][m][0]), sig4(acc[ai][bj][m][1])); }
        }
    }
};
struct EpiQ {
    static constexpr bool PERM = true, AFTER_DRAIN = false;
    const float* ssq; bf16_t* QM; const float* RM;
    DI void operator()(ACC_ARG, const Unit& u, int wr, int wc, int fr, int fq) const {
        asm volatile("" : "+v"(fr), "+v"(fq));
        const int pn = u.pn, rb = u.pm * 256 + wr * 64 + fr, cw = wc * 32 + fq * 8;
        FOR_AM { const int row = rb + ai * 128 + m * 16; const f32x4 s4 = *(const f32x4*)(ssq + row * 4);
            const float rs = rsqrtf(((s4[0] + s4[1]) + (s4[2] + s4[3])) * (1.f / 256.f) + EPS) * QS_MLA;
            if (pn < 2) {
#pragma unroll
                for (int bj = 0; bj < 2; ++bj) { const int c = pn * 256 + bj * 128 + cw;
                    *(u32x4*)(QM + (size_t)row * 768 + (c >> 6) * 96 + (c & 63)) = pack8(acc[ai][bj][m][0] * rs, acc[ai][bj][m][1] * rs); }
            } else { const int pos = row & (SEQ - 1);
#pragma unroll
                for (int bj = 0; bj < 2; ++bj) { f32x4 a = acc[ai][bj][m][0] * rs, b = acc[ai][bj][m][1] * rs; rope4(a, b, RM + (pos * 16 + 4 * fq) * 2);
                    bf16_t* p = QM + (size_t)row * 768 + (4 * bj + wc) * 96 + 64 + 4 * fq; *(u32x2*)p = pack4(a); *(u32x2*)(p + 16) = pack4(b); } }
            asm volatile("" ::: "memory");
        }
    }
};
struct EpiKV {
    static constexpr bool PERM = true, AFTER_DRAIN = false;
    const float* sskv; bf16_t *KM, *VM;
    DI void operator()(ACC_ARG, const Unit& u, int wr, int wc, int fr, int fq) const {
        asm volatile("" : "+v"(fr), "+v"(fq));
        const int pn = u.pn, rb = u.pm * 256 + wr * 64 + fr;
        FOR_AM { const int row = rb + ai * 128 + m * 16; const f32x4 s4 = *(const f32x4*)(sskv + row * 4);
            const float rs = rsqrtf(((s4[0] + s4[1]) + (s4[2] + s4[3])) * (1.f / 128.f) + EPS);
#pragma unroll
            for (int bj = 0; bj < 2; ++bj) { const int head = 2 * pn + bj; const u32x4 w = pack8(acc[ai][bj][m][0] * rs, acc[ai][bj][m][1] * rs);
                if (wc < 2) *(u32x4*)(KM + (size_t)row * 768 + head * 96 + wc * 32 + fq * 8) = w;
                else        *(u32x4*)(VM + (size_t)row * 512 + head * 64 + (wc - 2) * 32 + fq * 8) = w; }
            asm volatile("" ::: "memory");
        }
    }
};
struct EpiBr1 {
    static constexpr bool PERM = true, AFTER_DRAIN = false;
    const bf16_t* G; float* T;
    DI void operator()(ACC_ARG, const Unit& u, int wr, int wc, int fr, int fq) const {
        asm volatile("" : "+v"(fr), "+v"(fq));
        const int rb = u.pm * 256 + wr * 64 + fr, cb = u.pn * 256 + wc * 32 + fq * 8;
        FOR_AM { const int row = rb + ai * 128 + m * 16;
#pragma unroll
            for (int bj = 0; bj < 2; ++bj) { const int c = cb + bj * 128; const u32x4 gw = *(const u32x4*)(G + (size_t)row * 2048 + c);
                const f32x4 g0 = {bf_lo(gw.x), bf_hi(gw.x), bf_lo(gw.y), bf_hi(gw.y)}, g1 = {bf_lo(gw.z), bf_hi(gw.z), bf_lo(gw.w), bf_hi(gw.w)};
                float* tp = T + (size_t)row * 1024 + c; *(f32x4*)tp = acc[ai][bj][m][0] * g0; *(f32x4*)(tp + 4) = acc[ai][bj][m][1] * g1; } }
    }
};
struct EpiBr2 {
    static constexpr bool PERM = true, AFTER_DRAIN = false;
    const bf16_t* G; const float* T; bf16_t* MIX;
    DI void operator()(ACC_ARG, const Unit& u, int wr, int wc, int fr, int fq) const {
        asm volatile("" : "+v"(fr), "+v"(fq));
        const int rb = u.pm * 256 + wr * 64 + fr, cb = u.pn * 256 + wc * 32 + fq * 8;
        FOR_AM { const int row = rb + ai * 128 + m * 16;
#pragma unroll
            for (int bj = 0; bj < 2; ++bj) { const int c = cb + bj * 128; const u32x4 gw = *(const u32x4*)(G + (size_t)row * 2048 + 1024 + c);
                const f32x4 g0 = {bf_lo(gw.x), bf_hi(gw.x), bf_lo(gw.y), bf_hi(gw.y)}, g1 = {bf_lo(gw.z), bf_hi(gw.z), bf_lo(gw.w), bf_hi(gw.w)};
                const float* tp = T + (size_t)row * 1024 + c; const f32x4 t0 = *(const f32x4*)tp, t1 = *(const f32x4*)(tp + 4);
                *(u32x4*)(MIX + (size_t)row * 1024 + c) = pack8(t0 + acc[ai][bj][m][0] * g0, t1 + acc[ai][bj][m][1] * g1); } }
    }
};
struct EpiF32SS {
    static constexpr bool PERM = true, AFTER_DRAIN = false;
    float* O; float* ss;
    DI void operator()(ACC_ARG, const Unit& u, int wr, int wc, int fr, int fq) const {
        asm volatile("" : "+v"(fr), "+v"(fq));
        const int rb = u.pm * 256 + wr * 64 + fr, cb = u.pn * 256 + wc * 32 + fq * 8;
        FOR_AM { const int row = rb + ai * 128 + m * 16; float s = 0.f;
#pragma unroll
            for (int bj = 0; bj < 2; ++bj) { const f32x4 v0 = acc[ai][bj][m][0], v1 = acc[ai][bj][m][1]; s += sumsq4(v0) + sumsq4(v1);
                float* op = O + (size_t)row * 1024 + cb + bj * 128; *(f32x4*)op = v0; *(f32x4*)(op + 4) = v1; }
            s += __shfl_xor(s, 16); s += __shfl_xor(s, 32); if (fq == 0) ss[row * 16 + u.pn * 4 + wc] = s; }
    }
};
struct EpiUp {
    static constexpr bool PERM = true, AFTER_DRAIN = false;
    bf16_t* H;
    DI void operator()(ACC_ARG, const Unit& u, int wr, int wc, int fr, int fq) const {
        asm volatile("" : "+v"(fr), "+v"(fq));
        const int rb = u.pm * 256 + wr * 64 + fr, cb = u.pn * 256 + wc * 32 + fq * 8;
        FOR_AM { const int row = rb + ai * 128 + m * 16;
#pragma unroll
            for (int bj = 0; bj < 2; ++bj) { f32x4 v0 = acc[ai][bj][m][0], v1 = acc[ai][bj][m][1];
#pragma unroll
                for (int e = 0; e < 4; ++e) { const float a = fmaxf(v0[e], 0.f), b = fmaxf(v1[e], 0.f); v0[e] = a * a; v1[e] = b * b; }
                *(u32x4*)(H + (size_t)row * FF + cb + bj * 128) = pack8(v0, v1); } }
    }
};

template <int MODE> DI int src_col(int c) {
    if (MODE == 0) return c;
    if (MODE == 1) {
        if (c < 256) return c;
        if (c < 512) { int p = c - 256; if (p < 128) return 256 + p; p -= 128; if (p >= 32) return -1; return 384 + 16 * ((p >> 2) & 1) + 4 * (p >> 3) + (p & 3); }
        if (c < 2560) { const int cr = c - 512, head = cr >> 6, p = cr & 63; return 416 + head * 64 + 32 * ((p >> 2) & 1) + 4 * (p >> 3) + (p & 3); }
        return c - 96;
    }
    if (c < 512) return (c >> 6) * 96 + (c & 63);
    const int cr = c - 512, head = cr >> 5, p = cr & 31; return head * 96 + 64 + 16 * ((p >> 2) & 1) + 4 * (p >> 3) + (p & 3);
}
template <int MODE> DI void transpose_item(const float* W, int K, int Nsrc, int Ngemm, bf16_t* WT, const float* gain, LAS float* scr, int item, int lane) {
    const int nblk = Ngemm / 32, kb = item / nblk, nb = item % nblk, k0 = 64 * kb, n0 = 32 * nb;
    const int sc = src_col<MODE>(n0 + (lane & 31));
#pragma unroll 8
    for (int i = 0; i < 32; ++i) { const int kk = 2 * i + (lane >> 5); float v = 0.f;
        if (sc >= 0) { v = W[(size_t)(k0 + kk) * Nsrc + sc]; if (gain) v *= gain[k0 + kk]; }
        scr[kk * 33 + (lane & 31)] = v; }
    asm volatile("s_waitcnt lgkmcnt(0)" ::: "memory");
    const int c = lane & 7;
#pragma unroll
    for (int j = 0; j < 4; ++j) { const int n = (lane >> 3) + 8 * j; const LAS float* s = scr + (8 * c) * 33 + n;
        u32x4 o; o.x = cvt_pk_bf16(s[0 * 33], s[1 * 33]); o.y = cvt_pk_bf16(s[2 * 33], s[3 * 33]); o.z = cvt_pk_bf16(s[4 * 33], s[5 * 33]); o.w = cvt_pk_bf16(s[6 * 33], s[7 * 33]);
        *(u32x4*)(WT + (size_t)(n0 + n) * K + k0 + 8 * c) = o; }
    asm volatile("s_waitcnt lgkmcnt(0)" ::: "memory");
}
DI void rope_entry(float* dst, int pos, float expo) {
    const float inv = __builtin_amdgcn_exp2f(-expo * 13.287712379549449f);
    const float ang = (float)pos * inv;
    const double rev = (double)ang * 0.15915494309189535;
    const float fr = (float)(rev - __builtin_rint(rev));
    dst[0] = __builtin_amdgcn_cosf(fr); dst[1] = __builtin_amdgcn_sinf(fr);
}
DI void rms_row_to_bf16(const float* xrow, const float* g, bf16_t* orow, int lane) {
    const f32x4* xr = (const f32x4*)xrow + lane; const f32x4* gr = (const f32x4*)g + lane;
    f32x4 v[4]; float s = 0.f;
#pragma unroll
    for (int j = 0; j < 4; ++j) { v[j] = xr[64 * j]; s += sumsq4(v[j]); }
    const float rs = rsqrtf(wave_sum(s) * (1.f / DM) + EPS);
    u32x2* o8 = (u32x2*)orow + lane;
#pragma unroll
    for (int j = 0; j < 4; ++j) o8[64 * j] = pack4(v[j] * rs * gr[64 * j]);
}

namespace att {
typedef short bf16x8 __attribute__((ext_vector_type(8)));
typedef short s16x4 __attribute__((ext_vector_type(4)));
typedef float f32x16 __attribute__((ext_vector_type(16)));
#define MFMA32(a, b, c) __builtin_amdgcn_mfma_f32_32x32x16_bf16((a), (b), (c), 0, 0, 0)
DI s16x4 vtr(const LAS unsigned char* p) { return __builtin_bit_cast(s16x4, __builtin_amdgcn_ds_read_tr16_b64_v4i16((LAS s16x4*)p)); }
DI bf16x8 packp(const f32x16& x, int s) { u32x4 w; w.x = cvt_pk_bf16(x[8 * s], x[8 * s + 1]); w.y = cvt_pk_bf16(x[8 * s + 2], x[8 * s + 3]); w.z = cvt_pk_bf16(x[8 * s + 4], x[8 * s + 5]); w.w = cvt_pk_bf16(x[8 * s + 6], x[8 * s + 7]); return __builtin_bit_cast(bf16x8, w); }

template <bool DIFF>
DI void attn_unit(const bf16_t* Q, const bf16_t* __restrict__ K, const bf16_t* __restrict__ V, bf16_t* O, int b, int h, int qb, LAS unsigned char* lds, float lam, const float* subg, bool do_store = true) {
    constexpr int DQK = DIFF ? 64 : 96, DV = DIFF ? 128 : 64, NKS = DQK / 16, NDB = DV / 32;
    constexpr int KPITCH = DQK * 2 + 16, VPITCH = DV * 2 + 64, KT = 64 * KPITCH, VT = 64 * VPITCH, NK = DIFF ? 2 : 1, BUF = NK * KT + VT;
    constexpr int ROWS = DIFF ? 128 : 256, QP = DIFF ? 1024 : 768, VP = DIFF ? 1024 : 512, NST = DIFF ? 4 : 3;
    const int tid = threadIdx.x, lane = tid & 63, r = lane & 31, hh = lane >> 5;
    const int wid = __builtin_amdgcn_readfirstlane(tid >> 6);
    const int wrow = DIFF ? (wid & 3) : wid, map = DIFF ? (wid >> 2) : 0;
    const int q0 = qb * ROWS, qw0 = q0 + 32 * wrow;
    const size_t rowbase = (size_t)b * SEQ;
    bf16x8 qf[NKS];
    { const bf16_t* Qp = Q + (rowbase + qw0 + r) * QP + (DIFF ? (2 * h + map) * 64 : h * 96) + hh * 8;
#pragma unroll
      for (int ks = 0; ks < NKS; ++ks) qf[ks] = *(const bf16x8*)(Qp + ks * 16); }
    const bf16_t* src[NST]; unsigned dst[NST]; size_t tstep[NST]; bool ok1 = true;
    if (DIFF) {
        const int kr = tid >> 3, kc = tid & 7;
        src[0] = K + (rowbase + kr) * 1024 + (2 * h) * 64 + kc * 8; src[1] = src[0] + 64; dst[0] = kr * KPITCH + kc * 16; dst[1] = KT + dst[0];
        const int vr = tid >> 4, vc = tid & 15;
        src[2] = V + (rowbase + vr) * 1024 + h * 128 + vc * 8; src[3] = src[2] + 32 * 1024; dst[2] = 2 * KT + vr * VPITCH + vc * 16; dst[3] = dst[2] + 32 * VPITCH;
        tstep[0] = tstep[1] = tstep[2] = tstep[3] = (size_t)64 * 1024;
    } else {
        const int r0 = tid / 12, c0 = tid % 12, id1 = tid + 512, r1 = id1 / 12, c1 = id1 % 12; ok1 = tid < 256;
        src[0] = K + (rowbase + r0) * 768 + h * 96 + c0 * 8; dst[0] = r0 * KPITCH + c0 * 16;
        src[1] = K + (rowbase + (ok1 ? r1 : 0)) * 768 + h * 96 + c1 * 8; dst[1] = r1 * KPITCH + c1 * 16;
        const int vr = tid >> 3, vc = tid & 7;
        src[2] = V + (rowbase + vr) * 512 + h * 64 + vc * 8; dst[2] = KT + vr * VPITCH + vc * 16;
        tstep[0] = tstep[1] = (size_t)64 * 768; tstep[2] = (size_t)64 * 512;
    }
    u32x4 st[NST];
#define ATT_LOAD(t) do { _Pragma("unroll") for (int i_ = 0; i_ < NST; ++i_) if (i_ != 1 || ok1) st[i_] = *(const u32x4*)(src[i_] + (size_t)(t) * tstep[i_]); } while (0)
#define ATT_STORE(bufp) do { _Pragma("unroll") for (int i_ = 0; i_ < NST; ++i_) if (i_ != 1 || ok1) *(LAS u32x4*)((bufp) + dst[i_]) = st[i_]; } while (0)
    f32x16 o[NDB];
#pragma unroll
    for (int db = 0; db < NDB; ++db)
#pragma unroll
        for (int i = 0; i < 16; ++i) o[db][i] = 0.f;
    float m_run = -INFINITY, l_run = 0.f;
    const int nt = (q0 + ROWS) / 64;
    const int i16 = lane & 15, q4 = i16 >> 2, pp = i16 & 3, g1 = (lane >> 4) & 1;
    ATT_LOAD(0); ATT_STORE(lds); __syncthreads();
    for (int t = 0; t < nt; ++t) {
        const bool more = t + 1 < nt;
        if (more) ATT_LOAD(t + 1);
        LAS unsigned char* buf = lds + (t & 1) * BUF;
        if (64 * t <= qw0) {
            const LAS unsigned char* Kb = buf + (DIFF ? map * KT : 0) + r * KPITCH + hh * 16;
            f32x16 x0, x1;
#pragma unroll
            for (int i = 0; i < 16; ++i) { x0[i] = 0.f; x1[i] = 0.f; }
#pragma unroll
            for (int ks = 0; ks < NKS; ++ks) {
                const bf16x8 a0 = *(const LAS bf16x8*)(Kb + ks * 32), a1 = *(const LAS bf16x8*)(Kb + 32 * KPITCH + ks * 32);
                x0 = MFMA32(a0, qf[ks], x0); x1 = MFMA32(a1, qf[ks], x1);
            }
            if (64 * t + 63 > qw0) {
                const int qi = qw0 + r, kb0 = 64 * t + 4 * hh;
#pragma unroll
                for (int i = 0; i < 16; ++i) { const int key = kb0 + (i & 3) + 8 * (i >> 2); if (key > qi) x0[i] = -INFINITY; if (key + 32 > qi) x1[i] = -INFINITY; }
            }
            float mx = fmaxf(x0[0], x1[0]);
#pragma unroll
            for (int i = 1; i < 16; ++i) mx = fmaxf(mx, fmaxf(x0[i], x1[i]));
            mx = fmaxf(mx, __shfl_xor(mx, 32));
            const float m_new = fmaxf(m_run, mx), alpha = __builtin_amdgcn_exp2f(m_run - m_new); m_run = m_new;
            float ps = 0.f;
#pragma unroll
            for (int i = 0; i < 16; ++i) { x0[i] = __builtin_amdgcn_exp2f(x0[i] - m_new); x1[i] = __builtin_amdgcn_exp2f(x1[i] - m_new); ps += x0[i] + x1[i]; }
            l_run = l_run * alpha + ps;
#pragma unroll
            for (int db = 0; db < NDB; ++db)
#pragma unroll
                for (int i = 0; i < 16; ++i) o[db][i] *= alpha;
            bf16x8 pk[2][2]; pk[0][0] = packp(x0, 0); pk[0][1] = packp(x0, 1); pk[1][0] = packp(x1, 0); pk[1][1] = packp(x1, 1);
            const LAS unsigned char* Vb = buf + NK * KT + (4 * hh + q4) * VPITCH + (16 * g1 + 4 * pp) * 2;
#pragma unroll
            for (int db = 0; db < NDB; ++db)
#pragma unroll
                for (int kb = 0; kb < 2; ++kb)
#pragma unroll
                    for (int s = 0; s < 2; ++s) {
                        const LAS unsigned char* vp = Vb + (32 * kb + 16 * s) * VPITCH + db * 64;
                        const s16x4 lo = vtr(vp), hi = vtr(vp + 8 * VPITCH);
                        const bf16x8 vf = __builtin_shufflevector(lo, hi, 0, 1, 2, 3, 4, 5, 6, 7);
                        o[db] = MFMA32(vf, pk[kb][s], o[db]);
                    }
        }
        if (more) ATT_STORE(lds + ((t + 1) & 1) * BUF);
        __syncthreads();
    }
#undef ATT_LOAD
#undef ATT_STORE
    const float l = l_run + __shfl_xor(l_run, 32), inv = 1.0f / l;
    if (DIFF) {
        LAS float* scr = (LAS float*)lds + wrow * 4096;
        if (map == 1) { const float f = lam * inv;
#pragma unroll
            for (int db = 0; db < NDB; ++db)
#pragma unroll
                for (int i = 0; i < 16; ++i) scr[(db * 16 + i) * 64 + lane] = o[db][i] * f; }
        __syncthreads();
        if (map == 0 && do_store) { float ss = 0.f;
#pragma unroll
            for (int db = 0; db < NDB; ++db)
#pragma unroll
                for (int i = 0; i < 16; ++i) { const float v = o[db][i] * inv - scr[(db * 16 + i) * 64 + lane]; o[db][i] = v; ss += v * v; }
            ss += __shfl_xor(ss, 32);
            const float rs = rsqrtf(ss * (1.f / 128.f) + EPS) * 0.8f;
            bf16_t* op = O + (rowbase + qw0 + r) * 1024 + h * 128 + 4 * hh;
#pragma unroll
            for (int db = 0; db < NDB; ++db)
#pragma unroll
                for (int g = 0; g < 4; ++g) { const int d = 32 * db + 8 * g; const f32x4 gg = *(const f32x4*)(subg + d + 4 * hh);
                    const f32x4 v = {o[db][4 * g] * rs * gg[0], o[db][4 * g + 1] * rs * gg[1], o[db][4 * g + 2] * rs * gg[2], o[db][4 * g + 3] * rs * gg[3]};
                    *(u32x2*)(op + d) = pack4(v); } }
        __syncthreads();
    } else {
        bf16_t* op = O + (rowbase + qw0 + r) * 512 + h * 64 + 4 * hh;
#pragma unroll
        for (int db = 0; db < NDB; ++db)
#pragma unroll
            for (int g = 0; g < 4; ++g) { const f32x4 v = {o[db][4 * g] * inv, o[db][4 * g + 1] * inv, o[db][4 * g + 2] * inv, o[db][4 * g + 3] * inv};
                *(u32x2*)(op + 32 * db + 8 * g) = pack4(v); }
    }
}
}

#define XB_TMO      128
#define XB_XCNT(j)  (256  + 64 * (j))
#define XB_XSUB(j)  (1280 + 64 * (j))
#define XB_XGEN(j)  (2304 + 64 * (j))
#define XB_TOP      3328
#define XB_TOPGEN   3392
#define XCD_BAR_WORDS 3456
#define XB_SPIN_CAP (1u << 18)

__device__ __forceinline__ unsigned xb_ld(unsigned* p)              { return __hip_atomic_load(p, __ATOMIC_RELAXED, __HIP_MEMORY_SCOPE_AGENT); }
__device__ __forceinline__ unsigned xb_add(unsigned* p, unsigned v) { return __hip_atomic_fetch_add(p, v, __ATOMIC_RELAXED, __HIP_MEMORY_SCOPE_AGENT); }
__device__ __forceinline__ unsigned xb_xcc_id() { return (unsigned)__builtin_amdgcn_s_getreg((3 << 11) | 20) & 0xFu; }
#define XB_SPIN(cond, bar) do { unsigned _sp = 0; while (cond) { __builtin_amdgcn_s_sleep(1); \
    if ((++_sp & 255u) == 0u) { if (xb_ld(&(bar)[XB_TMO])) break; if (_sp > XB_SPIN_CAP) { atomicAdd(&(bar)[XB_TMO], 1u); break; } } } } while (0)

struct XcdBarrier {
    unsigned* bar; unsigned x;
    volatile LAS unsigned* st;
};

__device__ __forceinline__ XcdBarrier xcd_barrier_post(unsigned* bar, volatile LAS unsigned* st) {
    XcdBarrier b; b.bar = bar; b.x = xb_xcc_id(); b.st = st;
    if (threadIdx.x == 0) (void)xb_add(&bar[XB_XCNT(b.x)], 1u);
    return b;
}
__device__ __forceinline__ void xcd_barrier_complete(unsigned* bar, unsigned x, unsigned& nloc, unsigned& nx) {
    const unsigned G = gridDim.x * gridDim.y * gridDim.z;
    unsigned sum, cnt, mine, sp = 0u;
    for (;;) {
        sum = 0u; cnt = 0u; mine = 0u;
#pragma unroll
        for (unsigned j = 0; j < 16; ++j) { const unsigned c = xb_ld(&bar[XB_XCNT(j)]); sum += c; cnt += (c > 0u) ? 1u : 0u; mine = (j == x) ? c : mine; }
        if (sum == G) break;
        __builtin_amdgcn_s_sleep(1);
        if ((++sp & 255u) == 0u) { if (xb_ld(&bar[XB_TMO])) break; if (sp > XB_SPIN_CAP) { atomicAdd(&bar[XB_TMO], 1u); break; } }
    }
    nloc = mine > 0u ? mine : 1u; nx = cnt > 0u ? cnt : 1u;
}

__device__ __forceinline__ void xcd_barrier(const XcdBarrier& b) {
    asm volatile("s_waitcnt vmcnt(0)" ::: "memory");
    __syncthreads();
    if (threadIdx.x == 0) {
        unsigned* bar = b.bar;
        __builtin_amdgcn_s_waitcnt(0);
        unsigned nloc = b.st[0], nx = b.st[1];
        if (nloc == 0u) { xcd_barrier_complete(bar, b.x, nloc, nx); b.st[0] = nloc; b.st[1] = nx; }
        const unsigned old = xb_add(&bar[XB_XSUB(b.x)], 1u);
        const unsigned gen = old / nloc;
        if (old + 1u == (gen + 1u) * nloc) {
            __builtin_amdgcn_fence(__ATOMIC_RELEASE, "agent");
            asm volatile("s_waitcnt vmcnt(0)" ::: "memory");
            const unsigned og = xb_add(&bar[XB_TOP], 1u);
            const unsigned tg = og / nx;
            if (og + 1u == (tg + 1u) * nx) xb_add(&bar[XB_TOPGEN], 1u);
            else XB_SPIN(xb_ld(&bar[XB_TOPGEN]) == tg, bar);
            __builtin_amdgcn_fence(__ATOMIC_ACQUIRE, "agent");
            xb_add(&bar[XB_XGEN(b.x)], 1u);
            asm volatile("s_waitcnt vmcnt(0)" ::: "memory");
        } else {
            XB_SPIN(xb_ld(&bar[XB_XGEN(b.x)]) == gen, bar);
            __builtin_amdgcn_fence(__ATOMIC_ACQUIRE, "agent");
            asm volatile("s_waitcnt vmcnt(0)" ::: "memory");
        }
    }
    __syncthreads();
}

struct Args { const float* in[20]; float* out; unsigned char* ws; int ph_lo, ph_hi, flags, pad; };
__global__ void __launch_bounds__(512, 2) fwd_megakernel(Args args) {
    extern __shared__ __attribute__((aligned(16))) unsigned char lds_raw[];
    LAS unsigned char* lds = (LAS unsigned char*)lds_raw;
    const int tid = threadIdx.x, lane = tid & 63, wave = __builtin_amdgcn_readfirstlane(tid >> 6);
    const int G = gridDim.x, bx = blockIdx.x;
    const int vcu = (G % 8 == 0) ? (bx % 8) * (G / 8) + bx / 8 : bx;
    unsigned char* ws = args.ws;
    const float* x = args.in[0];
    bf16_t *Win_t = (bf16_t*)(ws + WS_WIN), *Wup_t = (bf16_t*)(ws + WS_WUP), *Wdown_t = (bf16_t*)(ws + WS_WDOWN), *Wbrd_t = (bf16_t*)(ws + WS_WBRD), *Wout_t = (bf16_t*)(ws + WS_WOUT),
           *Wbrm_t = (bf16_t*)(ws + WS_WBRM), *Wqb_t = (bf16_t*)(ws + WS_WQB), *Wkvb_t = (bf16_t*)(ws + WS_WKVB);
    bf16_t *QD = (bf16_t*)(ws + WS_QD), *KD = (bf16_t*)(ws + WS_KD), *VD = (bf16_t*)(ws + WS_VD), *QM = (bf16_t*)(ws + WS_QM), *KM = (bf16_t*)(ws + WS_KM), *VM = (bf16_t*)(ws + WS_VM),
           *QA = (bf16_t*)(ws + WS_QA), *CKV = (bf16_t*)(ws + WS_CKV), *XN = (bf16_t*)(ws + WS_XN), *OM = (bf16_t*)(ws + WS_OM), *MIX = (bf16_t*)(ws + WS_MIX), *HB = (bf16_t*)(ws + WS_H);
    bf16_t* GB = (bf16_t*)args.out;
    float *Tb = (float*)(ws + WS_T), *Yb = (float*)(ws + WS_Y), *Mo = (float*)(ws + WS_MO);
    float *ssq = (float*)(ws + WS_CTL + CT_SSQ), *sskv = (float*)(ws + WS_CTL + CT_SSKV), *ssy = (float*)(ws + WS_CTL + CT_SSY), *ssm = (float*)(ws + WS_CTL + CT_SSM),
          *RD = (float*)(ws + WS_CTL + CT_RD), *RM = (float*)(ws + WS_CTL + CT_RM);
    const int lo = args.ph_lo, hi = args.ph_hi;
#define IN(k) (lo <= (k) && (k) < hi)
#if MK_N_LAUNCHES == 1
    volatile LAS unsigned* MISC = (volatile LAS unsigned*)(lds + MISC_OFF);
    if (tid < 2) MISC[tid] = 0u;
    __syncthreads();
    const XcdBarrier bar = xcd_barrier_post((unsigned*)(ws + WS_CTL + CT_BAR), MISC);
#define SEAM(k) do { if (IN(k) && IN((k) + 1)) { if ((k) == 0) cg::this_grid().sync(); else xcd_barrier(bar); } } while (0)
#else
#define SEAM(k) do { } while (0)
#endif
    const int gw = vcu * 8 + wave, NGW = G * 8;

    if (IN(0)) {
        LAS float* scr = (LAS float*)(lds + wave * 16384);
        constexpr int I_IN = 16 * (NPROJ / 32), I_QB = 4 * 24, I_KVB = 2 * 32, I_BRM = 8 * 32, I_BRD = 16 * 32, I_OUT = 16 * 32, I_UP = 16 * 128, I_DN = 64 * 32;
        constexpr int NITEMS = I_IN + I_QB + I_KVB + I_BRM + I_BRD + I_OUT + I_UP + I_DN;
        for (int it = gw; it < NITEMS; it += NGW) {
            int r = it;
            if (r < I_IN) { transpose_item<1>(args.in[2], 1024, 5536, NPROJ, Win_t, nullptr, scr, r, lane); continue; } r -= I_IN;
            if (r < I_QB) { transpose_item<2>(args.in[4], 256, 768, 768, Wqb_t, args.in[3], scr, r, lane); continue; } r -= I_QB;
            if (r < I_KVB) { transpose_item<0>(args.in[6], 128, 1024, 1024, Wkvb_t, args.in[5], scr, r, lane); continue; } r -= I_KVB;
            if (r < I_BRM) { transpose_item<0>(args.in[12], 512, 1024, 1024, Wbrm_t, nullptr, scr, r, lane); continue; } r -= I_BRM;
            if (r < I_BRD) { transpose_item<0>(args.in[13], 1024, 1024, 1024, Wbrd_t, nullptr, scr, r, lane); continue; } r -= I_BRD;
            if (r < I_OUT) { transpose_item<0>(args.in[14], 1024, 1024, 1024, Wout_t, nullptr, scr, r, lane); continue; } r -= I_OUT;
            if (r < I_UP) { transpose_item<0>(args.in[17], 1024, 4096, 4096, Wup_t, nullptr, scr, r, lane); continue; } r -= I_UP;
            transpose_item<0>(args.in[18], 4096, 1024, 1024, Wdown_t, nullptr, scr, r, lane);
        }
        for (int e = vcu * 512 + tid; e < SEQ * 48; e += G * 512) {
            if (e < SEQ * 32) rope_entry(RD + 2 * e, e >> 5, (float)(e & 31) * (1.f / 32.f));
            else { const int e2 = e - SEQ * 32; rope_entry(RM + 2 * e2, e2 >> 4, (float)(e2 & 15) * (1.f / 16.f)); }
        }
        for (int m = gw; m < M; m += NGW) rms_row_to_bf16(x + (size_t)m * DM, args.in[1], XN + (size_t)m * DM, lane);
    }
    SEAM(0);
    if (IN(1)) {
        pg8::Gemm g{XN, Win_t, M, NPROJ, DM}; pg8::StaticOrder S; S.init(M, NPROJ, G, bx);
        EpiProj E{QA, CKV, KM, QD, KD, VD, GB, ssq, sskv, RD, RM};
        pg8::gemm_phase<EpiProj, pg8::StaticOrder, true, true>(lds, g, S, E);
    }
    SEAM(1);
    if (IN(2)) {
        { int kq = 256; asm volatile("" : "+s"(kq)); pg8::Gemm g{QA, Wqb_t, M, 768, kq}; pg8::StaticOrder S; S.init(M, 768, G, bx); EpiQ E{ssq, QM, RM};
          pg8::gemm_phase<EpiQ, pg8::StaticOrder, true, true>(lds, g, S, E); }
        { int kk = 128; asm volatile("" : "+s"(kk)); pg8::Gemm g{CKV, Wkvb_t, M, 1024, kk}; pg8::StaticOrder S; S.init(M, 1024, G, (bx + 192) % G); EpiKV E{sskv, KM, VM};
          pg8::gemm_phase<EpiKV, pg8::StaticOrder, true, true>(lds, g, S, E); }
    }
    SEAM(2);
    if (IN(3)) {
        float lam;
        { const float a = args.in[7][lane] * args.in[8][lane], b = args.in[9][lane] * args.in[10][lane];
          lam = __builtin_amdgcn_exp2f(wave_sum(a) * LOG2E) - __builtin_amdgcn_exp2f(wave_sum(b) * LOG2E) + 0.2f; }
        for (int v = vcu; v < 256; v += G) {
            const int bh = v >> 2, pr = v & 3, b = bh >> 3, h = bh & 7;
            att::attn_unit<false>(QM, KM, VM, OM, b, h, 7 - pr, lds, 0.f, nullptr);
            att::attn_unit<false>(QM, KM, VM, OM, b, h, pr, lds, 0.f, nullptr);
#pragma unroll 1
            for (int k = 0; k < 4; ++k) { const int p0 = 2 * pr + (k >> 1), qb = (k & 1) ? p0 : 15 - p0;
                att::attn_unit<true>(QD, KD, VD, QD, b, h, qb, lds, lam, args.in[11], (args.flags & 1) == 0); }
        }
    }
    SEAM(3);
    if (IN(4)) {
        { pg8::Gemm g{OM, Wbrm_t, M, DM, 512}; pg8::StaticOrder S; S.init(M, DM, G, bx); EpiBr1 E{GB, Tb};
          pg8::gemm_phase<EpiBr1, pg8::StaticOrder, true, true>(lds, g, S, E); }
        { pg8::Gemm g{QD, Wbrd_t, M, DM, DM}; pg8::StaticOrder S; S.init(M, DM, G, bx); EpiBr2 E{GB, Tb, MIX};
          pg8::gemm_phase<EpiBr2, pg8::StaticOrder, true, true>(lds, g, S, E); }
    }
    SEAM(4);
    if (IN(5)) {
        pg8::Gemm g{MIX, Wout_t, M, DM, DM}; pg8::StaticOrder S; S.init(M, DM, G, bx); EpiF32SS E{Yb, ssy};
        pg8::gemm_phase<EpiF32SS, pg8::StaticOrder, true, true>(lds, g, S, E);
    }
    SEAM(5);
    if (IN(6)) {
        const f32x4* g1 = (const f32x4*)args.in[15] + lane; const f32x4* g2 = (const f32x4*)args.in[16] + lane;
        for (int m = gw; m < M; m += NGW) {
            const f32x4* yr = (const f32x4*)(Yb + (size_t)m * DM) + lane; const f32x4* xr = (const f32x4*)(x + (size_t)m * DM) + lane;
            const f32x4* sp = (const f32x4*)(ssy + m * 16); const f32x4 sa = sp[0] + sp[1] + sp[2] + sp[3];
            const float rs1 = rsqrtf(((sa[0] + sa[1]) + (sa[2] + sa[3])) * (1.f / DM) + EPS);
            f32x4 v[4]; float s = 0.f;
#pragma unroll
            for (int j = 0; j < 4; ++j) { v[j] = xr[64 * j] + yr[64 * j] * rs1 * g1[64 * j]; s += sumsq4(v[j]); }
            f32x4* orow = (f32x4*)(args.out + (size_t)m * DM) + lane;
#pragma unroll
            for (int j = 0; j < 4; ++j) orow[64 * j] = v[j];
            const float rs2 = rsqrtf(wave_sum(s) * (1.f / DM) + EPS);
            u32x2* o8 = (u32x2*)(XN + (size_t)m * DM) + lane;
#pragma unroll
            for (int j = 0; j < 4; ++j) o8[64 * j] = pack4(v[j] * rs2 * g2[64 * j]);
        }
    }
    SEAM(6);
    if (IN(7)) {
        pg8::Gemm g{XN, Wup_t, M, FF, DM}; pg8::StaticOrder S; S.init(M, FF, G, bx); EpiUp E{HB};
        pg8::gemm_phase<EpiUp, pg8::StaticOrder, true, true>(lds, g, S, E);
    }
    SEAM(7);
    if (IN(8)) {
        pg8::Gemm g{HB, Wdown_t, M, DM, FF}; pg8::StaticOrder S; S.init(M, DM, G, bx); EpiF32SS E{Mo, ssm};
        pg8::gemm_phase<EpiF32SS, pg8::StaticOrder, true, true>(lds, g, S, E);
    }
    SEAM(8);
    if (IN(9)) {
        const f32x4* g3 = (const f32x4*)args.in[19] + lane;
        for (int m = gw; m < M; m += NGW) {
            const f32x4* mr = (const f32x4*)(Mo + (size_t)m * DM) + lane; f32x4* orow = (f32x4*)(args.out + (size_t)m * DM) + lane;
            const f32x4* sp = (const f32x4*)(ssm + m * 16); const f32x4 sa = sp[0] + sp[1] + sp[2] + sp[3];
            const float rs = rsqrtf(((sa[0] + sa[1]) + (sa[2] + sa[3])) * (1.f / DM) + EPS);
#pragma unroll
            for (int j = 0; j < 4; ++j) orow[64 * j] = orow[64 * j] + mr[64 * j] * rs * g3[64 * j];
        }
    }
#undef IN
#undef SEAM
}

extern "C" void kernel_launch(void* const* d_in, const int* in_sizes, int n_in, void* d_out, int out_size, void* d_ws, size_t ws_size, hipStream_t stream) {
    static int grid = 0;
    if (grid == 0) {
        if (n_in != 20 || out_size != M * DM || ws_size < 244 * MiB) { fprintf(stderr, "kernel_launch: unexpected problem (n_in %d, out %d, ws %zu)\n", n_in, out_size, ws_size); grid = -1; return; }
        if (hipFuncSetAttribute((const void*)fwd_megakernel, hipFuncAttributeMaxDynamicSharedMemorySize, LDS_BYTES) != hipSuccess) { fprintf(stderr, "kernel_launch: hipFuncSetAttribute failed\n"); grid = -1; return; }
        int dev = 0, cus = 0, per_cu = 0;
        (void)hipGetDevice(&dev); (void)hipDeviceGetAttribute(&cus, hipDeviceAttributeMultiprocessorCount, dev);
        (void)hipOccupancyMaxActiveBlocksPerMultiprocessor(&per_cu, (const void*)fwd_megakernel, 512, LDS_BYTES);
        (void)hipGetLastError();
        grid = cus * (per_cu > 0 ? per_cu : 1); if (grid > 256) grid = 256; if (grid < 8) grid = 8;
    }
    if (grid < 0) return;
    Args a{};
    for (int i = 0; i < 20; ++i) a.in[i] = (const float*)d_in[i];
    a.out = (float*)d_out; a.ws = (unsigned char*)d_ws;
#if MK_N_LAUNCHES == 1
    a.ph_lo = 0; a.ph_hi = NPH;
    if (hipMemsetAsync((unsigned char*)d_ws + WS_CTL + CT_BAR, 0, BAR_BYTES, stream) != hipSuccess) { fprintf(stderr, "kernel_launch: memset of the barrier words failed\n"); return; }
    void* kargs[] = {&a};
    hipError_t e = hipLaunchCooperativeKernel((const void*)fwd_megakernel, dim3(grid), dim3(512), kargs, LDS_BYTES, stream);
    if (e != hipSuccess) fprintf(stderr, "kernel_launch: cooperative launch failed: %s (grid %d)\n", hipGetErrorString(e), grid);
#else
    for (int ph = 0; ph < NPH; ++ph) { a.ph_lo = ph; a.ph_hi = ph + 1;
#ifdef PROBE_PH
        if (ph == PROBE_PH) { a.flags = 1; hipLaunchKernelGGL(fwd_megakernel, dim3(grid), dim3(512), LDS_BYTES, stream, a); a.flags = 0; }
#endif
        hipLaunchKernelGGL(fwd_megakernel, dim3(grid), dim3(512), LDS_BYTES, stream, a); }
#endif
}
```
